# Optimizing an MI355X kernel written in HIP

```python
import jax
import jax.numpy as jnp
from jax import lax
import numpy as np


D_MODEL = 1024
BATCH = 32
SEQ = 2048
DEPTH = 1

CHUNK = 64
HEAD_DIM = 64
N_RWKV_HEADS = 8
N_FOX_HEADS = 8
D_RWKV = N_RWKV_HEADS * HEAD_DIM
D_FOX = N_FOX_HEADS * HEAD_DIM
D_MIX = D_RWKV + D_FOX
DECAY_LORA = 64
AAA_LORA = 64
GATE_LORA = 128
R_OFF = 0
K_OFF = D_RWKV
V_OFF = 2 * D_RWKV
WD_OFF = 3 * D_RWKV
AD_OFF = WD_OFF + DECAY_LORA
GD_OFF = AD_OFF + AAA_LORA
RWKV_COLS = GD_OFF + GATE_LORA
FOX_COLS = 4 * D_FOX + N_FOX_HEADS
D_IN = RWKV_COLS + FOX_COLS
Q_BLOCK = 128
N_EXPERTS = 32
TOP_K = 4
D_EXPERT = D_MODEL
SWIGLU_ALPHA = 1.702
SWIGLU_LIMIT = 7.0
EXPERT_BLOCK = 256
NORM_EPS = 1e-6
GN_EPS = 64e-5
N_MOD = 6

kernel_name = 'hybrid_rwkv7_fox_moe_adaln_block'


def rms_norm(x, g):
    xf = x.astype(jnp.float32)
    y = xf * lax.rsqrt(jnp.mean(xf * xf, axis=-1, keepdims=True) + NORM_EPS)
    return (y * g.astype(jnp.float32)).astype(x.dtype)


def modulate(h, shift, scale):
    return h * (1 + scale[:, None, :]) + shift[:, None, :]


def rwkv7_mix(p, mu_shift, w0, w2, a0, a2, g2, k_k, k_a, r_k, gn_w, gn_b):
    B, S, _ = p.shape
    out_dtype = p.dtype
    pf = p.astype(jnp.float32)
    p_prev = jnp.pad(pf, ((0, 0), (1, 0), (0, 0)))[:, :-1]
    pf = pf + mu_shift * (p_prev - pf)
    r = pf[..., R_OFF:K_OFF]
    k = pf[..., K_OFF:V_OFF]
    v = pf[..., V_OFF:WD_OFF]
    wd = pf[..., WD_OFF:AD_OFF]
    ad = pf[..., AD_OFF:GD_OFF]
    gd = pf[..., GD_OFF:RWKV_COLS]
    w = -jax.nn.softplus(-(w0 + jnp.tanh(wd) @ w2)) - 0.5
    decay = jnp.exp(-jnp.exp(w))
    a = jax.nn.sigmoid(a0 + ad @ a2)
    g = jax.nn.sigmoid(gd) @ g2
    hs = lambda t: t.reshape(B, S, N_RWKV_HEADS, HEAD_DIM)
    kk = hs(k * k_k)
    kk = kk / jnp.maximum(jnp.sqrt(jnp.sum(kk * kk, axis=-1, keepdims=True)), 1e-12)
    k = k * (1 + (a - 1) * k_a)
    r_h, k_h, v_h, d_h, a_h = hs(r), hs(k), hs(v), hs(decay), hs(a)

    def step(state, inp):
        r_t, k_t, v_t, d_t, kk_t, a_t = inp
        sa = jnp.einsum('bhvk,bhk->bhv', state, -kk_t)
        state = (state * d_t[:, :, None, :]
                 + sa[..., None] * (kk_t * a_t)[:, :, None, :]
                 + v_t[..., None] * k_t[:, :, None, :])
        y_t = jnp.einsum('bhvk,bhk->bhv', state, r_t)
        return state, y_t

    xs = tuple(jnp.moveaxis(t, 1, 0) for t in (r_h, k_h, v_h, d_h, kk, a_h))
    s0 = jnp.zeros((B, N_RWKV_HEADS, HEAD_DIM, HEAD_DIM), jnp.float32)
    _, y = lax.scan(step, s0, xs)
    y = jnp.moveaxis(y, 0, 1)
    mean = jnp.mean(y, axis=-1, keepdims=True)
    var = jnp.mean(jnp.square(y - mean), axis=-1, keepdims=True)
    y = ((y - mean) * lax.rsqrt(var + GN_EPS)).reshape(B, S, D_RWKV) * gn_w + gn_b
    bonus = jnp.sum(r_h * k_h * r_k, axis=-1, keepdims=True) * v_h
    y = y + bonus.reshape(B, S, D_RWKV)
    return (y * g).astype(out_dtype)


def fox_mix(p, b_f, q_norm_g, k_norm_g, o_norm_g):
    B, S, _ = p.shape
    hs = lambda t: t.reshape(B, S, N_FOX_HEADS, HEAD_DIM)
    q = rms_norm(hs(p[..., 0:D_FOX]), q_norm_g)
    k = rms_norm(hs(p[..., D_FOX:2 * D_FOX]), k_norm_g)
    v = hs(p[..., 2 * D_FOX:3 * D_FOX])
    og = p[..., 3 * D_FOX:4 * D_FOX]
    log_f = jax.nn.log_sigmoid(p[..., 4 * D_FOX:].astype(jnp.float32) + b_f.astype(jnp.float32))
    cum = jnp.transpose(jnp.cumsum(log_f, axis=1), (0, 2, 1))
    q, k, v = (jnp.transpose(t, (0, 2, 1, 3)) for t in (q, k, v))
    scale = HEAD_DIM ** -0.5
    outs = []
    for blk in range(S // Q_BLOCK):
        q0 = blk * Q_BLOCK
        kv_len = q0 + Q_BLOCK
        qb = q[:, :, q0:kv_len]
        kb = k[:, :, :kv_len]
        vb = v[:, :, :kv_len]
        s = jnp.einsum('bhqd,bhkd->bhqk', qb, kb).astype(jnp.float32) * scale
        s = s + cum[:, :, q0:kv_len, None] - cum[:, :, None, :kv_len]
        mask = (q0 + jnp.arange(Q_BLOCK))[:, None] >= jnp.arange(kv_len)[None, :]
        s = jnp.where(mask, s, -jnp.inf)
        pr = jax.nn.softmax(s, axis=-1)
        outs.append(jnp.einsum('bhqk,bhkd->bhqd', pr.astype(vb.dtype), vb))
    o = jnp.transpose(jnp.concatenate(outs, axis=2), (0, 2, 1, 3))
    o = rms_norm(o, o_norm_g).reshape(B, S, D_FOX)
    return o * jax.nn.sigmoid(og)


def moe_ffn(h, w_router, b_router, w_gate_up, b_gate_up, w_down, b_down):
    B, S, D = h.shape
    T = B * S
    ht = h.reshape(T, D)
    logits = (ht @ w_router).astype(jnp.float32) + b_router.astype(jnp.float32)
    top_val, top_idx = lax.top_k(logits, TOP_K)
    gates = jax.nn.softmax(top_val, axis=-1)
    n_slots = T * TOP_K
    flat_e = top_idx.reshape(-1)
    flat_tok = jnp.arange(n_slots, dtype=jnp.int32) // TOP_K
    flat_gate = gates.reshape(-1)
    order = jnp.argsort(flat_e)
    sorted_e = flat_e[order]
    counts = jnp.zeros((N_EXPERTS,), jnp.int32).at[flat_e].add(1)
    starts = jnp.cumsum(counts) - counts
    padded = (counts + EXPERT_BLOCK - 1) // EXPERT_BLOCK * EXPERT_BLOCK
    pad_ends = jnp.cumsum(padded)
    pad_starts = pad_ends - padded
    dest = pad_starts[sorted_e] + (jnp.arange(n_slots, dtype=jnp.int32) - starts[sorted_e])
    n_blocks = -(-n_slots // EXPERT_BLOCK) + N_EXPERTS
    cap = n_blocks * EXPERT_BLOCK
    buf_tok = jnp.full((cap,), T, jnp.int32).at[dest].set(flat_tok[order])
    buf_gate = jnp.zeros((cap,), jnp.float32).at[dest].set(flat_gate[order])
    block_starts = jnp.arange(n_blocks, dtype=jnp.int32) * EXPERT_BLOCK
    block_e = jnp.minimum(jnp.searchsorted(pad_ends, block_starts, side='right'), N_EXPERTS - 1)
    h_pad = jnp.concatenate([ht, jnp.zeros((1, D), ht.dtype)], axis=0)
    xb = h_pad[buf_tok].reshape(n_blocks, EXPERT_BLOCK, D)

    def expert_block(args):
        xblk, e = args
        gu = xblk @ w_gate_up[e] + b_gate_up[e]
        gate = jnp.minimum(gu[:, :D_EXPERT], SWIGLU_LIMIT)
        up = jnp.clip(gu[:, D_EXPERT:], -SWIGLU_LIMIT, SWIGLU_LIMIT)
        act = gate * jax.nn.sigmoid(SWIGLU_ALPHA * gate) * (up + 1)
        return act @ w_down[e] + b_down[e]

    yb = lax.map(expert_block, (xb, block_e))
    y = yb.reshape(cap, D) * buf_gate[:, None].astype(yb.dtype)
    out = jax.ops.segment_sum(y, buf_tok, num_segments=T + 1)[:T]
    return out.reshape(B, S, D)


def setup_inputs(seed: int = 0):
    key = jax.random.key(seed)
    ks = jax.random.split(key, 32)
    f32 = jnp.float32
    L = DEPTH
    nrm = lambda k, shape, s: jax.random.normal(k, shape, f32) * s
    gain = lambda k, shape: 1.0 + 0.05 * jax.random.normal(k, shape, f32)
    return {
        'x': nrm(ks[0], (BATCH, SEQ, D_MODEL), 1.0),
        'c': nrm(ks[1], (BATCH, D_MODEL), 1.0),
        'w_ada': nrm(ks[2], (L, D_MODEL, N_MOD * D_MODEL), D_MODEL ** -0.5),
        'b_ada': nrm(ks[3], (L, N_MOD * D_MODEL), 0.02),
        'norm1_g': gain(ks[4], (L, D_MODEL)),
        'w_in': nrm(ks[5], (L, D_MODEL, D_IN), D_MODEL ** -0.5),
        'mu_shift': jax.random.uniform(ks[6], (L, RWKV_COLS), f32),
        'w0': jax.random.uniform(ks[7], (L, D_RWKV), f32, -6.0, -1.0),
        'w2': nrm(ks[8], (L, DECAY_LORA, D_RWKV), 0.5 * DECAY_LORA ** -0.5),
        'a0': nrm(ks[9], (L, D_RWKV), 0.5),
        'a2': nrm(ks[10], (L, AAA_LORA, D_RWKV), AAA_LORA ** -0.5),
        'g2': nrm(ks[11], (L, GATE_LORA, D_RWKV), GATE_LORA ** -0.5),
        'k_k': 0.85 + nrm(ks[12], (L, D_RWKV), 0.05),
        'k_a': gain(ks[13], (L, D_RWKV)),
        'r_k': nrm(ks[14], (L, N_RWKV_HEADS, HEAD_DIM), 0.1),
        'gn_w': gain(ks[15], (L, D_RWKV)),
        'gn_b': nrm(ks[16], (L, D_RWKV), 0.02),
        'b_f': jax.random.uniform(ks[17], (L, N_FOX_HEADS), f32, 1.0, 5.0),
        'q_norm_g': gain(ks[18], (L, HEAD_DIM)),
        'k_norm_g': gain(ks[19], (L, HEAD_DIM)),
        'o_norm_g': gain(ks[20], (L, HEAD_DIM)),
        'w_out': nrm(ks[21], (L, D_MIX, D_MODEL), D_MIX ** -0.5),
        'norm2_g': gain(ks[22], (L, D_MODEL)),
        'w_router': nrm(ks[23], (L, D_MODEL, N_EXPERTS), D_MODEL ** -0.5),
        'b_router': nrm(ks[24], (L, N_EXPERTS), 0.01),
        'w_gate_up': nrm(ks[25], (L, N_EXPERTS, D_MODEL, 2 * D_EXPERT), D_MODEL ** -0.5),
        'b_gate_up': nrm(ks[26], (L, N_EXPERTS, 2 * D_EXPERT), 0.02),
        'w_down': nrm(ks[27], (L, N_EXPERTS, D_EXPERT, D_MODEL), D_EXPERT ** -0.5),
        'b_down': nrm(ks[28], (L, N_EXPERTS, D_MODEL), 0.02),
        'final_g': gain(ks[29], (D_MODEL,)),
    }


def reference(x, c, w_ada, b_ada, norm1_g, w_in, mu_shift, w0, w2, a0, a2, g2, k_k, k_a,
              r_k, gn_w, gn_b, b_f, q_norm_g, k_norm_g, o_norm_g, w_out, norm2_g,
              w_router, b_router, w_gate_up, b_gate_up, w_down, b_down, final_g):
    c_act = jax.nn.silu(c)
    for l in range(DEPTH):
        mod = c_act @ w_ada[l] + b_ada[l]
        shift1, scale1, gate1, shift2, scale2, gate2 = jnp.split(mod, N_MOD, axis=-1)
        h = modulate(rms_norm(x, norm1_g[l]), shift1, scale1)
        p = h @ w_in[l]
        y_rwkv = rwkv7_mix(p[..., :RWKV_COLS], mu_shift[l], w0[l], w2[l], a0[l], a2[l], g2[l],
                           k_k[l], k_a[l], r_k[l], gn_w[l], gn_b[l])
        y_fox = fox_mix(p[..., RWKV_COLS:], b_f[l], q_norm_g[l], k_norm_g[l], o_norm_g[l])
        y = jnp.concatenate([y_rwkv, y_fox], axis=-1) @ w_out[l]
        x = x + gate1[:, None, :] * y
        h = modulate(rms_norm(x, norm2_g[l]), shift2, scale2)
        x = x + gate2[:, None, :] * moe_ffn(h, w_router[l], b_router[l], w_gate_up[l],
                                            b_gate_up[l], w_down[l], b_down[l])
    return rms_norm(x, final_g)
```

```cpp
#include <hip/hip_runtime.h>
#include <hip/hip_bf16.h>
#include <cstdio>
#include <cstdint>
#include <cmath>
namespace pg8 {
#define PG8_LAS __attribute__((address_space(3)))
typedef unsigned short bf16_t;
typedef short bf16x8 __attribute__((ext_vector_type(8)));
typedef float f32x4 __attribute__((ext_vector_type(4)));
typedef float f32x2 __attribute__((ext_vector_type(2)));
typedef unsigned u32x4 __attribute__((ext_vector_type(4)));
typedef unsigned u32x2 __attribute__((ext_vector_type(2)));
typedef int i32x4 __attribute__((ext_vector_type(4)));
typedef int i32x8 __attribute__((ext_vector_type(8)));
constexpr int BM = 256, BK = 64, HALF = 128, HTB = HALF * BK * 2  , STAGE_BYTES = 8 * HTB, NXCD = 8, WGM = 8;

__host__ __device__ __forceinline__ int lds_byte(int r, int c) { const int st = (r >> 4) * 2 + (c >> 5), rr = r & 15, cc = c & 31, ob = rr * 64 + cc * 2; return st * 1024 + (ob ^ (((ob >> 9) & 1) << 5)); }
__host__ __device__ __forceinline__ void stage_rc(int b, int& R, int& C) { const int st = b / 1024, sb = b % 1024, swz = sb ^ (((sb >> 9) & 1) << 5); R = (st >> 1) * 16 + swz / 64; C = (st & 1) * 32 + (swz % 64) / 2; }
__host__ __device__ __forceinline__ int perm32(int rho) { const int n = rho >> 4, i = rho & 15; return 8 * (i >> 2) + 4 * n + (i & 3); }

struct Unit { int pm, pn, e; };
struct Gemm { const bf16_t* A; const bf16_t* Bt; int K; size_t bstride; };

struct StaticOrder {
    int nM, nN, nwg, G, c;
    __device__ __forceinline__ void init(int nM_, int nN_, int G_, int c_) { nM = nM_; nN = nN_; nwg = nM * nN; G = G_; c = c_; }
    __device__ __forceinline__ bool next(int i, Unit& u) const {
        const long L = (long)i * G + c; if (L >= nwg) return false;
        int wgid = (int)L; { const int q = nwg / NXCD, r = nwg % NXCD, xcd = wgid % NXCD, off = wgid / NXCD; wgid = (xcd < r ? xcd * (q + 1) : r * (q + 1) + (xcd - r) * q) + off; }
        const int nig = WGM * nN, gid = wgid / nig, fm = gid * WGM, gsz = (nM - fm) < WGM ? (nM - fm) : WGM;
        u.pm = fm + ((wgid % nig) % gsz); u.pn = (wgid % nig) / gsz; u.e = 0; return true;
    }
};
struct MoeOrder {
    StaticOrder so; const PG8_LAS unsigned char* blk2e;
    __device__ __forceinline__ bool next(int i, Unit& u) const { if (!so.next(i, u)) return false; u.e = blk2e[u.pm]; return true; }
};

__device__ __forceinline__ unsigned cvt_pk_bf16(float lo, float hi) { unsigned r; asm volatile("v_cvt_pk_bf16_f32 %0, %1, %2" : "=v"(r) : "v"(lo), "v"(hi)); return r; }

struct EpiBf16 {
    static constexpr bool PERM = true;
    struct Pre {}; __device__ __forceinline__ Pre pre(const Unit&, int, int) const { return Pre{}; }
    bf16_t* O; int ldc; const float* bias; int bias_stride; float scale;
    template <class PreT> __device__ __forceinline__ void operator()(const f32x4 (&acc)[2][2][4][2], const Unit& u, int wr, int wc, int fr, int fq, const PreT& P_) const {
        const int row0 = u.pm * BM + wr * 64 + fr; const int col0 = u.pn * BM + wc * 32 + 8 * fq;
        f32x4 bv[2][2];
#pragma unroll
        for (int bj = 0; bj < 2; ++bj)
#pragma unroll
            for (int n = 0; n < 2; ++n) bv[bj][n] = bias ? *(const f32x4*)(bias + (size_t)u.e * bias_stride + col0 + bj * HALF + 4 * n) : (f32x4){0.f, 0.f, 0.f, 0.f};
#pragma unroll
        for (int ai = 0; ai < 2; ++ai)
#pragma unroll
            for (int m = 0; m < 4; ++m) { bf16_t* rowp = O + (size_t)(row0 + ai * HALF + m * 16) * ldc + col0;
#pragma unroll
                for (int bj = 0; bj < 2; ++bj) { const f32x4 v0 = acc[ai][bj][m][0] * scale + bv[bj][0], v1 = acc[ai][bj][m][1] * scale + bv[bj][1];
                    u32x4 w; w.x = cvt_pk_bf16(v0[0], v0[1]); w.y = cvt_pk_bf16(v0[2], v0[3]); w.z = cvt_pk_bf16(v1[0], v1[1]); w.w = cvt_pk_bf16(v1[2], v1[3]);
                    *(u32x4*)(rowp + bj * HALF) = w; } }
    }
};
struct EpiBf16K {
    static constexpr bool PERM = true;
    struct Pre {}; __device__ __forceinline__ Pre pre(const Unit&, int, int) const { return Pre{}; }
    bf16_t* O; int ldc; float scale; const float* kg; int kt0;
    template <class PreT> __device__ __forceinline__ void operator()(const f32x4 (&acc)[2][2][4][2], const Unit& u, int wr, int wc, int fr, int fq, const PreT& P_) const {
        const int row0 = u.pm * BM + wr * 64 + fr;
        if (u.pn == kt0 || u.pn == kt0 + 1) {
            f32x4 g[2][2];
#pragma unroll
            for (int bj = 0; bj < 2; ++bj)
#pragma unroll
                for (int n = 0; n < 2; ++n) g[bj][n] = *(const f32x4*)(kg + 32 * bj + 8 * fq + 4 * n);
#pragma unroll
            for (int ai = 0; ai < 2; ++ai)
#pragma unroll
                for (int m = 0; m < 4; ++m) { bf16_t* rowp = O + (size_t)(row0 + ai * HALF + m * 16) * ldc + u.pn * BM + 64 * wc + 8 * fq;
                    f32x4 v[2][2]; float ss = 0.f;
#pragma unroll
                    for (int bj = 0; bj < 2; ++bj)
#pragma unroll
                        for (int n = 0; n < 2; ++n) { v[bj][n] = acc[ai][bj][m][n] * scale; ss += (v[bj][n][0] * v[bj][n][0] + v[bj][n][1] * v[bj][n][1]) + (v[bj][n][2] * v[bj][n][2] + v[bj][n][3] * v[bj][n][3]); }
                    { auto rr = __builtin_amdgcn_permlane16_swap(__float_as_uint(ss), __float_as_uint(ss), false, false); ss = __uint_as_float(rr[0]) + __uint_as_float(rr[1]); }
                    { auto rr = __builtin_amdgcn_permlane32_swap(__float_as_uint(ss), __float_as_uint(ss), false, false); ss = __uint_as_float(rr[0]) + __uint_as_float(rr[1]); }
                    const float rk = __builtin_amdgcn_rsqf(ss * (1.0f / 64.0f) + 1e-6f);
#pragma unroll
                    for (int bj = 0; bj < 2; ++bj) { const f32x4 v0 = v[bj][0] * rk * g[bj][0], v1 = v[bj][1] * rk * g[bj][1];
                        u32x4 w; w.x = cvt_pk_bf16(v0[0], v0[1]); w.y = cvt_pk_bf16(v0[2], v0[3]); w.z = cvt_pk_bf16(v1[0], v1[1]); w.w = cvt_pk_bf16(v1[2], v1[3]);
                        *(u32x4*)(rowp + 32 * bj) = w; } }
        } else {
            const int col0 = u.pn * BM + wc * 32 + 8 * fq;
#pragma unroll
            for (int ai = 0; ai < 2; ++ai)
#pragma unroll
                for (int m = 0; m < 4; ++m) { bf16_t* rowp = O + (size_t)(row0 + ai * HALF + m * 16) * ldc + col0;
#pragma unroll
                    for (int bj = 0; bj < 2; ++bj) { const f32x4 v0 = acc[ai][bj][m][0] * scale, v1 = acc[ai][bj][m][1] * scale;
                        u32x4 w; w.x = cvt_pk_bf16(v0[0], v0[1]); w.y = cvt_pk_bf16(v0[2], v0[3]); w.z = cvt_pk_bf16(v1[0], v1[1]); w.w = cvt_pk_bf16(v1[2], v1[3]);
                        *(u32x4*)(rowp + bj * HALF) = w; } }
        }
    }
};
struct EpiResGate {
    static constexpr bool PERM = true;
    struct Pre {}; __device__ __forceinline__ Pre pre(const Unit&, int, int) const { return Pre{}; }
    const float* base; bf16_t* out; int ldc; const float* gate; int gate_stride; int pm_per_b;
    template <class PreT> __device__ __forceinline__ void operator()(const f32x4 (&acc)[2][2][4][2], const Unit& u, int wr, int wc, int fr, int fq, const PreT& P_) const {
        const int row0 = u.pm * BM + wr * 64 + fr; const int col0 = u.pn * BM + wc * 32 + 8 * fq;
        const float* gp = gate + (size_t)(u.pm / pm_per_b) * gate_stride + col0;
        f32x4 gv[2][2];
#pragma unroll
        for (int bj = 0; bj < 2; ++bj)
#pragma unroll
            for (int n = 0; n < 2; ++n) gv[bj][n] = *(const f32x4*)(gp + bj * HALF + 4 * n);
#pragma unroll
        for (int ai = 0; ai < 2; ++ai)
#pragma unroll
            for (int m = 0; m < 4; ++m) { const size_t off = (size_t)(row0 + ai * HALF + m * 16) * ldc + col0;
#pragma unroll
                for (int bj = 0; bj < 2; ++bj) { const f32x4 v0 = *(const f32x4*)(base + off + bj * HALF) + gv[bj][0] * acc[ai][bj][m][0], v1 = *(const f32x4*)(base + off + bj * HALF + 4) + gv[bj][1] * acc[ai][bj][m][1];
                    u32x4 w; w.x = cvt_pk_bf16(v0[0], v0[1]); w.y = cvt_pk_bf16(v0[2], v0[3]); w.z = cvt_pk_bf16(v1[0], v1[1]); w.w = cvt_pk_bf16(v1[2], v1[3]);
                    *(u32x4*)(out + off + bj * HALF) = w; } }
    }
};
struct EpiSwiglu {
    static constexpr bool PERM = true;
    struct Pre {}; __device__ __forceinline__ Pre pre(const Unit&, int, int) const { return Pre{}; }
    bf16_t* O; int ldc; const float* bias; int bias_stride;
    int de;
    template <class PreT> __device__ __forceinline__ void operator()(const f32x4 (&acc)[2][2][4][2], const Unit& u, int wr, int wc, int fr, int fq, const PreT& P_) const {
        const int row0 = u.pm * BM + wr * 64 + fr; const int col0 = u.pn * HALF + wc * 32 + 8 * fq;
        const float* bp = bias + (size_t)u.e * bias_stride + col0;
        f32x4 bg[2], bu[2];
#pragma unroll
        for (int n = 0; n < 2; ++n) { bg[n] = *(const f32x4*)(bp + 4 * n); bu[n] = *(const f32x4*)(bp + de + 4 * n); }
#pragma unroll
        for (int ai = 0; ai < 2; ++ai)
#pragma unroll
            for (int m = 0; m < 4; ++m) { bf16_t* rowp = O + (size_t)(row0 + ai * HALF + m * 16) * ldc + col0;
                float r[8];
#pragma unroll
                for (int n = 0; n < 2; ++n) { const f32x4 g4 = acc[ai][0][m][n] + bg[n], u4 = acc[ai][1][m][n] + bu[n];
#pragma unroll
                    for (int i = 0; i < 4; ++i) { const float g = fminf(g4[i], 7.0f), uu = fminf(fmaxf(u4[i], -7.0f), 7.0f);
                        const float sg = __builtin_amdgcn_rcpf(1.0f + __builtin_amdgcn_exp2f(-1.702f * 1.4426950408889634f * g));
                        r[4 * n + i] = g * sg * (uu + 1.0f); } }
                u32x4 w; w.x = cvt_pk_bf16(r[0], r[1]); w.y = cvt_pk_bf16(r[2], r[3]); w.z = cvt_pk_bf16(r[4], r[5]); w.w = cvt_pk_bf16(r[6], r[7]);
                *(u32x4*)rowp = w; }
    }
};

__device__ __forceinline__ unsigned pk4_fp8(float a, float b, float c, float d) {
    int r = __builtin_amdgcn_cvt_pk_fp8_f32(__builtin_amdgcn_fmed3f(a, -448.f, 448.f), __builtin_amdgcn_fmed3f(b, -448.f, 448.f), 0, false);
    r = __builtin_amdgcn_cvt_pk_fp8_f32(__builtin_amdgcn_fmed3f(c, -448.f, 448.f), __builtin_amdgcn_fmed3f(d, -448.f, 448.f), r, true); return (unsigned)r; }
struct EpiSwigluFp8 {
    static constexpr bool PERM = true;
    struct Pre { f32x4 bg[2]; };
    __device__ __forceinline__ Pre pre(const Unit& u, int wc, int fq) const { Pre p; const float* bp = bias + (size_t)u.e * bias_stride + u.pn * HALF + wc * 32 + 8 * fq;
#pragma unroll
        for (int n = 0; n < 2; ++n) p.bg[n] = *(const f32x4*)(bp + 4 * n);
        return p; }
    unsigned char* O; int ldc; const float* bias; int bias_stride; int de; float iscale, oscale;
    template <class PreT> __device__ __forceinline__ void operator()(const f32x4 (&acc)[2][2][4][2], const Unit& u, int wr, int wc, int fr, int fq, const PreT& P_) const {
        const int row0 = u.pm * BM + wr * 64 + fr; const int col0 = u.pn * HALF + wc * 32 + 8 * fq;
        const float* bp = bias + (size_t)u.e * bias_stride + col0;
        f32x4 bg[2], bu[2];
#pragma unroll
        for (int n = 0; n < 2; ++n) { bg[n] = P_.bg[n]; bu[n] = *(const f32x4*)(bp + de + 4 * n); }
        const float c1 = -1.702f * 1.4426950408889634f, os = oscale;
#pragma unroll
        for (int ai = 0; ai < 2; ++ai)
#pragma unroll
            for (int m = 0; m < 4; ++m) { unsigned char* rowp = O + (size_t)(row0 + ai * HALF + m * 16) * ldc + col0;
                unsigned w[2];
#pragma unroll
                for (int n = 0; n < 2; ++n) { const f32x4 g4 = acc[ai][0][m][n] * iscale + bg[n], u4 = acc[ai][1][m][n] * iscale + bu[n];
                    typedef float f32x2v __attribute__((ext_vector_type(2)));
                    float r[4];
#pragma unroll
                    for (int i = 0; i < 4; i += 2) {
                        const f32x2v g = {fminf(g4[i], 7.0f), fminf(g4[i + 1], 7.0f)};
                        const f32x2v um = {__builtin_amdgcn_fmed3f(u4[i], -7.0f, 7.0f), __builtin_amdgcn_fmed3f(u4[i + 1], -7.0f, 7.0f)};
                        const f32x2v uo = um * os + os;
                        const f32x2v t = g * c1;
                        const f32x2v den = (f32x2v){__builtin_amdgcn_exp2f(t.x), __builtin_amdgcn_exp2f(t.y)} + 1.0f;
                        const f32x2v sg = {__builtin_amdgcn_rcpf(den.x), __builtin_amdgcn_rcpf(den.y)};
                        const f32x2v rr = (g * sg) * uo;
                        r[i] = rr.x; r[i + 1] = rr.y; }
                    int pk = __builtin_amdgcn_cvt_pk_fp8_f32(r[0], r[1], 0, false); pk = __builtin_amdgcn_cvt_pk_fp8_f32(r[2], r[3], pk, true); w[n] = (unsigned)pk; }
                *(u32x2*)rowp = (u32x2){w[0], w[1]}; }
    }
};

struct EpiFp8 {
    static constexpr bool PERM = true;
    struct Pre { f32x4 bv[2][2]; };
    __device__ __forceinline__ Pre pre(const Unit& u, int wc, int fq) const { Pre p; const float* bp = bias + (size_t)u.e * bias_stride + u.pn * BM + wc * 32 + 8 * fq;
#pragma unroll
        for (int bj = 0; bj < 2; ++bj)
#pragma unroll
            for (int n = 0; n < 2; ++n) p.bv[bj][n] = *(const f32x4*)(bp + bj * HALF + 4 * n);
        return p; }
    unsigned char* O; int ldc; const float* bias; int bias_stride; float scale, oscale;
    template <class PreT> __device__ __forceinline__ void operator()(const f32x4 (&acc)[2][2][4][2], const Unit& u, int wr, int wc, int fr, int fq, const PreT& P_) const {
        const int row0 = u.pm * BM + wr * 64 + fr; const int col0 = u.pn * BM + wc * 32 + 8 * fq;
        f32x4 bv[2][2];
#pragma unroll
        for (int bj = 0; bj < 2; ++bj)
#pragma unroll
            for (int n = 0; n < 2; ++n) bv[bj][n] = P_.bv[bj][n] * oscale;
        const float sc = scale * oscale;
#pragma unroll
        for (int ai = 0; ai < 2; ++ai)
#pragma unroll
            for (int m = 0; m < 4; ++m) { unsigned char* rowp = O + (size_t)(row0 + ai * HALF + m * 16) * ldc + col0;
#pragma unroll
                for (int bj = 0; bj < 2; ++bj) { const f32x4 v0 = acc[ai][bj][m][0] * sc + bv[bj][0], v1 = acc[ai][bj][m][1] * sc + bv[bj][1];
                    *(u32x2*)(rowp + bj * HALF) = (u32x2){pk4_fp8(v0[0], v0[1], v0[2], v0[3]), pk4_fp8(v1[0], v1[1], v1[2], v1[3])}; } }
    }
};

template <class Epi, class Sched, bool GATHER, bool FP8 = false, bool ALIGN_EPI = true>
__device__ __forceinline__ void gemm_phase(PG8_LAS unsigned char* lds, const Gemm g, const Sched& S, const Epi& E, const PG8_LAS unsigned short* rowtab, const int tid) {
    const int wid = __builtin_amdgcn_readfirstlane(tid >> 6), lane = tid & 63, wr = wid >> 2, wc = wid & 3, fr = lane & 15, fq = lane >> 4;
    constexpr int ES = FP8 ? 1 : 2;
    const int K = g.K, nt = K * ES / (BK * 2);
    unsigned voffB[2]; int RA[2], CA[2];
#pragma unroll
    for (int i = 0; i < 2; ++i) { int R, C; stage_rc(tid * 16 + i * 8192, R, C); const int Rb = Epi::PERM ? ((R & ~31) + perm32(R & 31)) : R;
        RA[i] = R; CA[i] = C; voffB[i] = (unsigned)(Rb * K * ES + C * 2); }
    const size_t kstep = (size_t)(BK * 2);
    const size_t hstep = (size_t)HALF * K * ES;
    const size_t tstep = 2 * hstep;
    const unsigned ldsw = (unsigned)wid * 1024u;
    const int aoff = lds_byte(wr * 64 + fr, fq * 8), boff = lds_byte(wc * 32 + fr, fq * 8);
#define PG8_SA(b, h) (((b) * 2 + (h)) * HTB)
#define PG8_SB(b, h) ((4 + (b) * 2 + (h)) * HTB)
#define PG8_STAGE(bufoff, gbase, voff) do { _Pragma("unroll") for (int _i = 0; _i < 2; ++_i) \
        __builtin_amdgcn_global_load_lds((const unsigned*)((const char*)(gbase) + (voff)[_i]), (PG8_LAS unsigned*)(lds + (bufoff) + ldsw + _i * 8192), 16, 0, 0); } while (0)
#define PG8_LDA(dst, b, h) do { _Pragma("unroll") for (int m = 0; m < 4; ++m) { const i32x4 lo_ = *(const PG8_LAS i32x4*)(lds + PG8_SA(b, h) + aoff + m * 2048), hi_ = *(const PG8_LAS i32x4*)(lds + PG8_SA(b, h) + aoff + m * 2048 + 1024); \
        dst[m] = __builtin_shufflevector(lo_, hi_, 0, 1, 2, 3, 4, 5, 6, 7); } } while (0)
#define PG8_LDB(dst, b, h) do { _Pragma("unroll") for (int n = 0; n < 2; ++n) { const i32x4 lo_ = *(const PG8_LAS i32x4*)(lds + PG8_SB(b, h) + boff + n * 2048), hi_ = *(const PG8_LAS i32x4*)(lds + PG8_SB(b, h) + boff + n * 2048 + 1024); \
        dst[n] = __builtin_shufflevector(lo_, hi_, 0, 1, 2, 3, 4, 5, 6, 7); } } while (0)
#define PG8_LO4(x) __builtin_bit_cast(bf16x8, __builtin_shufflevector(x, x, 0, 1, 2, 3))
#define PG8_HI4(x) __builtin_bit_cast(bf16x8, __builtin_shufflevector(x, x, 4, 5, 6, 7))
#define PG8_MMA(ai, bj, At, Bt) do { __builtin_amdgcn_s_setprio(1); _Pragma("unroll") for (int m = 0; m < 4; ++m) _Pragma("unroll") for (int n = 0; n < 2; ++n) { \
        if constexpr (FP8) asm volatile("v_mfma_f32_16x16x128_f8f6f4 %0, %1, %2, %0" : "+v"(acc[ai][bj][m][n]) : "v"(Bt[n]), "v"(At[m]));   \
        else { acc[ai][bj][m][n] = __builtin_amdgcn_mfma_f32_16x16x32_bf16(PG8_LO4(Bt[n]), PG8_LO4(At[m]), acc[ai][bj][m][n], 0, 0, 0); \
               acc[ai][bj][m][n] = __builtin_amdgcn_mfma_f32_16x16x32_bf16(PG8_HI4(Bt[n]), PG8_HI4(At[m]), acc[ai][bj][m][n], 0, 0, 0); } } \
        __builtin_amdgcn_s_setprio(0); } while (0)
#define PG8_WAIT_V(n) asm volatile("s_waitcnt vmcnt(" #n ")" ::: "memory")
#define PG8_WAIT_L(n) asm volatile("s_waitcnt lgkmcnt(" #n ")" ::: "memory")
#define PG8_BAR __builtin_amdgcn_s_barrier()
#define PG8_SCHED __builtin_amdgcn_sched_barrier(0)
#define PG8_AOFFS(dst0, dst1, u, uidx) do { _Pragma("unroll") for (int _i = 0; _i < 2; ++_i) { \
        if constexpr (GATHER) { const int r0_ = (int)rowtab[(uidx) * BM + RA[_i]], r1_ = (int)rowtab[(uidx) * BM + HALF + RA[_i]]; \
            dst0[_i] = (unsigned)(r0_ * K * ES + CA[_i] * 2); dst1[_i] = (unsigned)(r1_ * K * ES + CA[_i] * 2); } \
        else { dst0[_i] = (unsigned)(((u).pm * BM + RA[_i]) * K * ES + CA[_i] * 2); dst1[_i] = (unsigned)(((u).pm * BM + HALF + RA[_i]) * K * ES + CA[_i] * 2); } } } while (0)
    Unit cur, nxt; int ui = 0;
    if (!S.next(0, cur)) return;
    f32x4 acc[2][2][4][2];
#pragma unroll
    for (int a = 0; a < 2; ++a)
#pragma unroll
        for (int b = 0; b < 2; ++b)
#pragma unroll
            for (int m = 0; m < 4; ++m)
#pragma unroll
                for (int n = 0; n < 2; ++n) acc[a][b][m][n] = (f32x4){0.f, 0.f, 0.f, 0.f};
    i32x8 At[4], B0[2], B1[2];
    const char* const gA = (const char*)g.A;
    unsigned cA0[2], cA1[2], nA0[2], nA1[2];
    PG8_AOFFS(cA0, cA1, cur, 0);
    const char* cB = (const char*)g.Bt + ((size_t)cur.e * g.bstride) * ES + (size_t)cur.pn * tstep;
    PG8_STAGE(PG8_SB(0, 0), cB, voffB); PG8_STAGE(PG8_SB(0, 1), cB + hstep, voffB); PG8_STAGE(PG8_SA(0, 0), gA, cA0); PG8_STAGE(PG8_SA(0, 1), gA, cA1);
    if (wr == 1) PG8_BAR;
    PG8_WAIT_V(2); PG8_BAR;
    PG8_STAGE(PG8_SB(1, 0), cB + kstep, voffB); PG8_STAGE(PG8_SA(1, 0), gA + kstep, cA0); PG8_STAGE(PG8_SB(1, 1), cB + hstep + kstep, voffB);
    PG8_WAIT_V(6); PG8_BAR;
    for (;;) {
        const bool has_next = S.next(ui + 1, nxt);
        const char* nB = has_next ? (const char*)g.Bt + ((size_t)nxt.e * g.bstride) * ES + (size_t)nxt.pn * tstep : cB;
        if (has_next) { PG8_AOFFS(nA0, nA1, nxt, ui + 1); } else { nA0[0] = cA0[0]; nA0[1] = cA0[1]; nA1[0] = cA1[0]; nA1[1] = cA1[1]; }
        typename Epi::Pre epre;
#pragma nounroll
        for (int t = 0; t < nt; t += 2) {
            const bool last = (t == nt - 2);
            if (last) epre = E.pre(cur, wc, fq);
            const char* a1 = gA + (size_t)(t + 1) * kstep;
            const char* a2 = last ? gA : gA + (size_t)(t + 2) * kstep; const char* b2 = last ? nB : cB + (size_t)(t + 2) * kstep;
            const char* a3 = a2 + kstep; const char* b3 = b2 + kstep;
            unsigned xA0[2], xA1[2];
            xA0[0] = last ? nA0[0] : cA0[0]; xA0[1] = last ? nA0[1] : cA0[1]; xA1[0] = last ? nA1[0] : cA1[0]; xA1[1] = last ? nA1[1] : cA1[1];
            PG8_LDB(B0, 0, 0); PG8_LDB(B1, 0, 1); PG8_SCHED; PG8_LDA(At, 0, 0); PG8_STAGE(PG8_SA(1, 1), a1, cA1);
            PG8_WAIT_V(8); PG8_WAIT_L(0); PG8_BAR; PG8_MMA(0, 0, At, B0); PG8_MMA(0, 1, At, B1); PG8_BAR; PG8_SCHED;
            PG8_LDA(At, 0, 1); PG8_STAGE(PG8_SB(0, 0), b2, voffB); PG8_STAGE(PG8_SB(0, 1), b2 + hstep, voffB); PG8_STAGE(PG8_SA(0, 0), a2, xA0);
            PG8_WAIT_V(8); PG8_WAIT_L(0); PG8_BAR; PG8_MMA(1, 0, At, B0); PG8_MMA(1, 1, At, B1); PG8_BAR; PG8_SCHED;
            PG8_LDB(B0, 1, 0); PG8_LDB(B1, 1, 1); PG8_SCHED; PG8_LDA(At, 1, 0); PG8_STAGE(PG8_SA(0, 1), a2, xA1);
            PG8_WAIT_V(8); PG8_WAIT_L(0); PG8_BAR; PG8_MMA(0, 0, At, B0); PG8_MMA(0, 1, At, B1); PG8_BAR; PG8_SCHED;
            PG8_LDA(At, 1, 1); PG8_STAGE(PG8_SB(1, 0), b3, voffB); PG8_STAGE(PG8_SB(1, 1), b3 + hstep, voffB); PG8_STAGE(PG8_SA(1, 0), a3, xA0);
            PG8_WAIT_V(8); PG8_WAIT_L(0); PG8_BAR; PG8_MMA(1, 0, At, B0); PG8_MMA(1, 1, At, B1); PG8_BAR; PG8_SCHED;
        }
        if constexpr (ALIGN_EPI) if (wr == 0) PG8_BAR;
        if constexpr (FP8) asm volatile("s_nop 15\n\ts_nop 7" ::: "memory");
        E(acc, cur, wr, wc, fr, fq, epre);
        if (!has_next) break;
#pragma unroll
        for (int a = 0; a < 2; ++a)
#pragma unroll
            for (int b = 0; b < 2; ++b)
#pragma unroll
                for (int m = 0; m < 4; ++m)
#pragma unroll
                    for (int n = 0; n < 2; ++n) acc[a][b][m][n] = (f32x4){0.f, 0.f, 0.f, 0.f};
        cur = nxt; cB = nB; cA0[0] = nA0[0]; cA0[1] = nA0[1]; cA1[0] = nA1[0]; cA1[1] = nA1[1]; ++ui;
        if constexpr (ALIGN_EPI) if (wr == 1) PG8_BAR;
    }
    PG8_WAIT_V(0);
    if constexpr (!ALIGN_EPI) { if (wr == 0) PG8_BAR; }
    PG8_BAR;
#undef PG8_SA
#undef PG8_SB
#undef PG8_STAGE
#undef PG8_LDA
#undef PG8_LDB
#undef PG8_MMA
#undef PG8_LO4
#undef PG8_HI4
#undef PG8_WAIT_V
#undef PG8_WAIT_L
#undef PG8_BAR
#undef PG8_SCHED
#undef PG8_AOFFS
}
}
namespace attn_body {
using bf16=__hip_bfloat16;
using bf16x8=__attribute__((ext_vector_type(8)))short;
using s16x4=__attribute__((ext_vector_type(4)))short;
using f32x16=__attribute__((ext_vector_type(16)))float;
using u32x4=__attribute__((ext_vector_type(4)))unsigned;
using f32x4v=__attribute__((ext_vector_type(4)))float;
constexpr int BATCH=32,NHEAD=8,SEQ=2048,D=64,DM=3840,DMO=1024;
constexpr int NW=8,QBLK=32,QB=QBLK*NW,KVBLK=64,NQB=SEQ/QB;
constexpr int ATTN_UNIT_ROWS=QB;
__device__ __forceinline__ int crow(int r,int hi){return (r&3)+8*(r>>2)+4*hi;}
#define SBAR() __builtin_amdgcn_sched_barrier(0)
__device__ __forceinline__ void cmask(f32x16&p0,f32x16&p1,int jb,int qrel,int hi){
  const float NEG=-INFINITY; int kb=64*jb+4*hi;
  #pragma unroll
  for(int r=0;r<16;++r){int kv=kb+(r&3)+8*(r>>2); if(kv>qrel)p0[r]=NEG; if(kv+32>qrel)p1[r]=NEG;}
}

constexpr int NSLOT=3, SLOTB=8192;
constexpr int LDS_K=0, LDS_V=NSLOT*SLOTB, LDS_WS=2*NSLOT*SLOTB, LDS_OST=LDS_WS+NW*64*4, LDS_BIAS=LDS_OST+NW*4096, LDS_BYTES=LDS_BIAS+SEQ*4;
constexpr float C2=0.125f*1.4426950408889634f;
__device__ __forceinline__ void glds16(const void*gsrc,unsigned lds_dst){unsigned keep;
  asm volatile("s_mov_b32 %0, m0\n\ts_mov_b32 m0, %2\n\ts_nop 0\n\tglobal_load_lds_dwordx4 %1, off\n\ts_mov_b32 m0, %0":"=&s"(keep):"v"(gsrc),"s"(lds_dst):"memory");}
__device__ __forceinline__ float max3f(float a,float b,float c){float r;asm("v_max3_f32 %0, %1, %2, %3":"=v"(r):"v"(a),"v"(b),"v"(c));return r;}
__device__ __forceinline__ float max2f(float a,float b){float r;asm("v_max_f32_e32 %0, %1, %2":"=v"(r):"v"(a),"v"(b));return r;}
__device__ __forceinline__ float fadd_s(float a,float b){float r;asm("v_add_f32_e32 %0, %1, %2":"=v"(r):"v"(a),"v"(b));return r;}
__device__ __forceinline__ float fsub_s(float a,float b){float r;asm("v_sub_f32_e32 %0, %1, %2":"=v"(r):"v"(a),"v"(b));return r;}
typedef float f32x2_t __attribute__((ext_vector_type(2))); typedef __bf16 bf16x2_t __attribute__((ext_vector_type(2)));
__device__ __forceinline__ unsigned cvtpk_s(float lo,float hi){f32x2_t v={lo,hi};bf16x2_t b=__builtin_convertvector(v,bf16x2_t);return __builtin_bit_cast(unsigned,b);}
#define WAIT_BAR(N) asm volatile("s_waitcnt vmcnt(" #N ") lgkmcnt(0)\n\ts_barrier":::"memory")

__device__ __forceinline__ void qkt(f32x16&p0,f32x16&p1,const char*Kslot,const bf16x8*qr,int r32,int hi){
  const char*kb=Kslot+hi*1024+r32*16;
  #pragma unroll
  for(int d0=0;d0<4;++d0){
    const bf16x8 b0=*reinterpret_cast<const bf16x8*>(kb+d0*2048);
    const bf16x8 b1=*reinterpret_cast<const bf16x8*>(kb+d0*2048+512);
    p0=__builtin_amdgcn_mfma_f32_32x32x16_bf16(b0,qr[d0],p0,0,0,0);p1=__builtin_amdgcn_mfma_f32_32x32x16_bf16(b1,qr[d0],p1,0,0,0);}
}
typedef __attribute__((address_space(3))) const char* lds_cptr;
typedef short v4i16_t __attribute__((ext_vector_type(4)));
__device__ __forceinline__ void kload8(bf16x8*kf,lds_cptr kp){
  kf[0]=*(const __attribute__((address_space(3))) bf16x8*)(kp);      kf[1]=*(const __attribute__((address_space(3))) bf16x8*)(kp+512);
  kf[2]=*(const __attribute__((address_space(3))) bf16x8*)(kp+2048); kf[3]=*(const __attribute__((address_space(3))) bf16x8*)(kp+2560);
  kf[4]=*(const __attribute__((address_space(3))) bf16x8*)(kp+4096); kf[5]=*(const __attribute__((address_space(3))) bf16x8*)(kp+4608);
  kf[6]=*(const __attribute__((address_space(3))) bf16x8*)(kp+6144); kf[7]=*(const __attribute__((address_space(3))) bf16x8*)(kp+6656);
}
__device__ __forceinline__ void kload2(bf16x8*kf,lds_cptr kp,int j){ kf[2*j]=*(const __attribute__((address_space(3))) bf16x8*)(kp+j*2048); kf[2*j+1]=*(const __attribute__((address_space(3))) bf16x8*)(kp+j*2048+512); }
__device__ __forceinline__ s16x4 vtr(lds_cptr p){ return __builtin_bit_cast(s16x4,__builtin_amdgcn_ds_read_tr16_b64_v4i16((__attribute__((address_space(3))) v4i16_t*)p)); }
__device__ __forceinline__ float rowmax(const f32x16&p0,const f32x16&p1){
  float a=max3f(p0[0],p0[1],p1[0]),b=max3f(p0[2],p0[3],p1[1]);a=max3f(a,p1[2],p1[3]);
  #pragma unroll
  for(int r=4;r<16;r+=4){a=max3f(a,p0[r],p0[r+1]);b=max3f(b,p0[r+2],p0[r+3]);a=max3f(a,p1[r],p1[r+1]);b=max3f(b,p1[r+2],p1[r+3]);}
  const float m=max2f(a,b);
  auto rr=__builtin_amdgcn_permlane32_swap(__float_as_uint(m),__float_as_uint(m),false,false);
  return max2f(__uint_as_float(rr[0]),__uint_as_float(rr[1]));
}
__device__ __forceinline__ void pv(f32x16*o,int vb,bf16x8 pa0,bf16x8 pa1,bf16x8 pa2,bf16x8 pa3){
  #pragma unroll
  for(int d0=0;d0<2;++d0){s16x4 lo[4],hi[4];
    #pragma unroll
    for(int ks=0;ks<4;++ks){
      asm volatile("ds_read_b64_tr_b16 %0,%1 offset:%c2":"=&v"(lo[ks]):"v"(vb),"i"(d0*4096+ks*1024):"memory");
      asm volatile("ds_read_b64_tr_b16 %0,%1 offset:%c2":"=&v"(hi[ks]):"v"(vb),"i"(d0*4096+ks*1024+512):"memory");}
    asm volatile("s_waitcnt lgkmcnt(0)":::"memory");SBAR();
    #define PK(k) (bf16x8){lo[k][0],lo[k][1],lo[k][2],lo[k][3],hi[k][0],hi[k][1],hi[k][2],hi[k][3]}
    o[d0]=__builtin_amdgcn_mfma_f32_32x32x16_bf16(pa0,PK(0),o[d0],0,0,0);
    o[d0]=__builtin_amdgcn_mfma_f32_32x32x16_bf16(pa1,PK(1),o[d0],0,0,0);
    o[d0]=__builtin_amdgcn_mfma_f32_32x32x16_bf16(pa2,PK(2),o[d0],0,0,0);
    o[d0]=__builtin_amdgcn_mfma_f32_32x32x16_bf16(pa3,PK(3),o[d0],0,0,0);
    #undef PK
  }
}

#ifndef ATTN_STORE16
#define ATTN_STORE16(p,v) (*(u32x4*)(p)=(v))
#endif
template<int THRL,int VAR=0> __device__ __forceinline__ void attn_unit(int b,int h,int qb,const bf16*Q,const bf16*__restrict__ K,const bf16*__restrict__ V,const bf16*__restrict__ OG,const float*__restrict__ GO,const float*__restrict__ GQ,bf16*O,char*shm,const int tid){
  const int lane=tid&63,r32=lane&31,hi=lane>>5; const int wid=__builtin_amdgcn_readfirstlane(tid>>6);
  const long rowbase=(long)b*SEQ; const int q0=qb*QB;
  const bf16*Qw=Q+(rowbase+q0+wid*QBLK)*DM+h*D;
  const bf16*Kh=K+rowbase*DM+h*D,*Vh=V+rowbase*DM+h*D;
  const unsigned lds0=(unsigned)(uintptr_t)shm;
  float*wsf=(float*)(shm+LDS_WS)+wid*64;
  const bf16*ksrc=Kh+(long)lane*DM+wid*8;
  const bf16*vsrc=Vh+(long)(16*(wid&3)+(lane>>2))*DM+(wid>>2)*32+(lane&3)*8;
  const unsigned kdst=lds0+LDS_K+wid*1024, vdst=lds0+LDS_V+wid*1024;
  #define DMA_K(t,slot) glds16(ksrc+(long)(t)*KVBLK*DM,(unsigned)__builtin_amdgcn_readfirstlane(kdst+(slot)))
  #define DMA_V(t,slot) glds16(vsrc+(long)(t)*KVBLK*DM,(unsigned)__builtin_amdgcn_readfirstlane(vdst+(slot)))
  const int vb0=(int)(lds0+LDS_V)+((lane>>4)&1)*32+(lane&3)*8+(4*hi+((lane&15)>>2))*64;
  const char*Kbase=shm+LDS_K; bf16x8 kf[8];
  const lds_cptr shm3=(lds_cptr)shm; const lds_cptr kp0=shm3+LDS_K+hi*1024+r32*16; const lds_cptr vp0=shm3+LDS_V+((lane>>4)&1)*32+(lane&3)*8+(4*hi+((lane&15)>>2))*64;
  const __attribute__((address_space(3))) float*biasl=(const __attribute__((address_space(3))) float*)(shm3+LDS_BIAS)+4*hi;
  const int NT=(q0+QB)/KVBLK;
  DMA_K(0,0);DMA_V(0,0);DMA_K(1,SLOTB);
  bf16x8 qr[4];
  #pragma unroll
  for(int d0=0;d0<4;++d0)qr[d0]=*reinterpret_cast<const bf16x8*>(&Qw[(long)r32*DM+d0*16+hi*8]);
  {
    float qf[32]; float ssq=0.f;
    #pragma unroll
    for(int d0=0;d0<4;++d0){
      #pragma unroll
      for(int j=0;j<8;++j){ qf[8*d0+j]=__uint_as_float(((unsigned)(unsigned short)qr[d0][j])<<16); ssq+=qf[8*d0+j]*qf[8*d0+j]; } }
    { auto rr=__builtin_amdgcn_permlane32_swap(__float_as_uint(ssq),__float_as_uint(ssq),false,false); ssq=__uint_as_float(rr[0])+__uint_as_float(rr[1]); }
    const float rq=__builtin_amdgcn_rsqf(ssq*(1.0f/64.0f)+1e-6f)*C2;
    #pragma unroll
    for(int d0=0;d0<4;++d0){ u32x4 w_;
      #pragma unroll
      for(int j=0;j<4;++j) w_[j]=cvtpk_s(qf[8*d0+2*j]*rq*GQ[d0*16+hi*8+2*j],qf[8*d0+2*j+1]*rq*GQ[d0*16+hi*8+2*j+1]);
      qr[d0]=__builtin_bit_cast(bf16x8,w_); } }
  float mhat=0.f,l_reg=0.f;f32x16 o[2];o[0]=f32x16{};o[1]=f32x16{};
  const int qrel=wid*QBLK+r32;
  mhat=*((const __attribute__((address_space(3))) float*)(shm3+LDS_BIAS)+q0+qrel)+6.0f;
  #define CMASK(P0,P1,t) do{int jb_=(t)-(NT-4); if(jb_>=0)cmask(P0,P1,jb_,qrel,hi);}while(0)
  #define CINIT(P0,P1,t) do{ if constexpr(VAR==1){ _Pragma("unroll") for(int r_=0;r_<16;++r_){ P0[r_]=-mhat; P1[r_]=-mhat; } } else { \
      const __attribute__((address_space(3))) float*bt_=biasl+(t)*KVBLK; const f32x4v nm_={-mhat,-mhat,-mhat,-mhat}; _Pragma("unroll") for(int g_=0;g_<4;++g_){ \
      const f32x4v b0_=*(const __attribute__((address_space(3))) f32x4v*)(bt_+8*g_)+nm_, b1_=*(const __attribute__((address_space(3))) f32x4v*)(bt_+32+8*g_)+nm_; \
      _Pragma("unroll") for(int i_=0;i_<4;++i_){ P0[4*g_+i_]=b0_[i_]; P1[4*g_+i_]=b1_[i_]; } } } }while(0)
  bool resc=false;
  #define START(P0,P1) do{ const float rm=rowmax(P0,P1); resc=false; \
    { const float dl=rm>(float)THRL?rm:0.f; mhat=fadd_s(mhat,dl); \
      _Pragma("unroll") for(int r=0;r<16;++r){P0[r]=fsub_s(P0[r],dl);P1[r]=fsub_s(P1[r],dl);} \
      } \
    _Pragma("unroll") for(int r=0;r<16;++r)P0[r]=__builtin_amdgcn_exp2f(P0[r]); }while(0)
  #define RESC() do{ if(resc){ asm volatile("s_waitcnt lgkmcnt(0)":::"memory"); \
      _Pragma("unroll") for(int d_=0;d_<2;++d_) _Pragma("unroll") for(int r=0;r<16;++r)o[d_][r]*=wsf[crow(r,hi)]; } }while(0)
  f32x16 pA0,pA1,pB0,pB1;
  int sl_prev=0,sl_cur=0,sl_next=SLOTB;
  #define ROT() do{sl_prev=sl_cur;sl_cur=sl_next;sl_next=(sl_next==(NSLOT-1)*SLOTB)?0:sl_next+SLOTB;}while(0)
  DMA_K(2,2*SLOTB);
  WAIT_BAR(3);
  CINIT(pA0,pA1,0);qkt(pA0,pA1,Kbase,qr,r32,hi);asm volatile("s_nop 15\n\ts_nop 7":"+v"(pA0),"+v"(pA1));CMASK(pA0,pA1,0);
  START(pA0,pA1);
  _Pragma("unroll") for(int r=0;r<16;++r)pA1[r]=__builtin_amdgcn_exp2f(pA1[r]);
  WAIT_BAR(0);
  DMA_K(3,0);DMA_V(1,SLOTB);
  ROT();
  kload8(kf,kp0+sl_cur);
  WAIT_BAR(2);
  s16x4 vlo[8],vhi[8]; u32x4 pw0,pw1,pw2,pw3;
  #define PKW(P,B) cvtpk_s(P[B],P[B+1])
  #define PAF(k) __builtin_bit_cast(bf16x8,pw##k)
  #define VFR(i) (bf16x8){vlo[i][0],vlo[i][1],vlo[i][2],vlo[i][3],vhi[i][0],vhi[i][1],vhi[i][2],vhi[i][3]}
  #define PIN(x) asm volatile("":"+v"(x))
  #define MX3(a,b,c) __builtin_fmaxf(__builtin_fmaxf((a),(b)),(c))
  #define GAPA(MF,A0,A1,A2,A3,W0,W1,PW) do{ MF; sacc+=A0; sacc+=A1; sacc+=A2; sacc+=A3; PIN(sacc); W0; W1; PIN(PW); SBAR(); }while(0)
  #define EX(v) __builtin_amdgcn_exp2f(v)
  #define GAPB(MF,X,B) do{ MF; X[B]=EX(X[B]); X[B+1]=EX(X[B+1]); X[B+2]=EX(X[B+2]); X[B+3]=EX(X[B+3]); PIN(X); SBAR(); }while(0)
  #define VRD(i) do{ vlo[i]=vtr(vp_+(((i)>>2)*4096+((i)&3)*1024)); vhi[i]=vtr(vp_+(((i)>>2)*4096+((i)&3)*1024+512)); }while(0)
  #define KRD(G,j) do{ if(G){ kload2(kf,kp0+sl_next,j); SBAR(); } }while(0)
  #define STEP(C0,C1,P0,P1,t,GK,GV,GL) do{ CINIT(C0,C1,t); SBAR(); \
    const lds_cptr vp_=vp0+sl_prev; \
    VRD(0); SBAR(); float sacc=(P0[0]+P0[1]); \
    GAPA(C0=__builtin_amdgcn_mfma_f32_32x32x16_bf16(kf[0],qr[0],C0,0,0,0), P0[2],P0[3],P0[4],P0[5],     pw0[0]=PKW(P0,0), pw0[1]=PKW(P0,2), pw0); \
    VRD(4); SBAR(); GAPA(C1=__builtin_amdgcn_mfma_f32_32x32x16_bf16(kf[1],qr[0],C1,0,0,0), P0[6],P0[7],P0[8],P0[9],     pw0[2]=PKW(P0,4), pw0[3]=PKW(P0,6), pw0); \
    VRD(1); SBAR(); GAPA(C0=__builtin_amdgcn_mfma_f32_32x32x16_bf16(kf[2],qr[1],C0,0,0,0),   P0[10],P0[11],P0[12],P0[13], pw1[0]=PKW(P0,8), pw1[1]=PKW(P0,10), pw1); \
    VRD(5); SBAR(); GAPA(C1=__builtin_amdgcn_mfma_f32_32x32x16_bf16(kf[3],qr[1],C1,0,0,0),   P0[14],P0[15],P1[0],P1[1],   pw1[2]=PKW(P0,12),pw1[3]=PKW(P0,14), pw1); \
    VRD(2); SBAR(); GAPA(C0=__builtin_amdgcn_mfma_f32_32x32x16_bf16(kf[4],qr[2],C0,0,0,0),   P1[2],P1[3],P1[4],P1[5],     pw2[0]=PKW(P1,0), pw2[1]=PKW(P1,2), pw2); \
    VRD(6); SBAR(); GAPA(C1=__builtin_amdgcn_mfma_f32_32x32x16_bf16(kf[5],qr[2],C1,0,0,0),   P1[6],P1[7],P1[8],P1[9],     pw2[2]=PKW(P1,4), pw2[3]=PKW(P1,6), pw2); \
    VRD(3); SBAR(); GAPA(C0=__builtin_amdgcn_mfma_f32_32x32x16_bf16(kf[6],qr[3],C0,0,0,0),   P1[10],P1[11],P1[12],P1[13], pw3[0]=PKW(P1,8), pw3[1]=PKW(P1,10), pw3); \
    VRD(7); SBAR(); GAPA(C1=__builtin_amdgcn_mfma_f32_32x32x16_bf16(kf[7],qr[3],C1,0,0,0),   P1[14],P1[15],0.f,0.f,       pw3[2]=PKW(P1,12),pw3[3]=PKW(P1,14), pw3); \
    l_reg+=sacc; \
    if(GK){DMA_K((t)+3,sl_cur);} if(GV){DMA_V((t)+1,sl_next);} \
    CMASK(C0,C1,t); \
    { float a=MX3(C0[0],C0[1],C1[0]),b=MX3(C0[2],C0[3],C1[1]); a=MX3(a,C1[2],C1[3]); \
      _Pragma("unroll") for(int r=4;r<16;r+=4){a=MX3(a,C0[r],C0[r+1]);b=MX3(b,C0[r+2],C0[r+3]);a=MX3(a,C1[r],C1[r+1]);b=MX3(b,C1[r+2],C1[r+3]);} \
      float rm=__builtin_fmaxf(a,b); { auto rr=__builtin_amdgcn_permlane32_swap(__float_as_uint(rm),__float_as_uint(rm),false,false); rm=__builtin_fmaxf(__uint_as_float(rr[0]),__uint_as_float(rr[1])); } \
      resc=false; \
      if(__builtin_expect(__any(rm>(float)THRL),0)){ const float dl=__builtin_fmaxf(rm,0.f); mhat+=dl; \
        _Pragma("unroll") for(int r=0;r<16;++r){C0[r]-=dl;C1[r]-=dl;} \
        const float f=__builtin_amdgcn_exp2f(-dl); l_reg*=f; if(hi==0)wsf[r32]=f; resc=true; } } \
    SBAR(); \
    GAPB(o[0]=__builtin_amdgcn_mfma_f32_32x32x16_bf16(PAF(0),VFR(0),o[0],0,0,0), C0,0); \
    GAPB(o[1]=__builtin_amdgcn_mfma_f32_32x32x16_bf16(PAF(0),VFR(4),o[1],0,0,0), C0,4); \
    KRD(GL,0); GAPB(o[0]=__builtin_amdgcn_mfma_f32_32x32x16_bf16(PAF(1),VFR(1),o[0],0,0,0), C0,8); \
    KRD(GL,1); GAPB(o[1]=__builtin_amdgcn_mfma_f32_32x32x16_bf16(PAF(1),VFR(5),o[1],0,0,0), C0,12); \
    KRD(GL,2); GAPB(o[0]=__builtin_amdgcn_mfma_f32_32x32x16_bf16(PAF(2),VFR(2),o[0],0,0,0), C1,0); \
    KRD(GL,3); GAPB(o[1]=__builtin_amdgcn_mfma_f32_32x32x16_bf16(PAF(2),VFR(6),o[1],0,0,0), C1,4); \
    GAPB(o[0]=__builtin_amdgcn_mfma_f32_32x32x16_bf16(PAF(3),VFR(3),o[0],0,0,0), C1,8); \
    GAPB(o[1]=__builtin_amdgcn_mfma_f32_32x32x16_bf16(PAF(3),VFR(7),o[1],0,0,0), C1,12); \
    }while(0)
  int t=1;
  #undef CMASK
  #define CMASK(P0,P1,t) do{}while(0)
  for(;t+5<NT;t+=2){
    STEP(pB0,pB1,pA0,pA1,t,true,true,true);     WAIT_BAR(2); RESC(); ROT();
    STEP(pA0,pA1,pB0,pB1,t+1,true,true,true);   WAIT_BAR(2); RESC(); ROT();
  }
  #undef CMASK
  #define CMASK(P0,P1,t) do{int jb_=(t)-(NT-4); if(jb_>=0)cmask(P0,P1,jb_,qrel,hi);}while(0)
  #define ENDW(tt) do{ if((tt)+3<NT){WAIT_BAR(2);} else if((tt)+2<NT){WAIT_BAR(1);} else {WAIT_BAR(0);} }while(0)
  for(;t+1<NT;t+=2){
    STEP(pB0,pB1,pA0,pA1,t,(t+3<NT),(t+1<NT),(t+1<NT));       ENDW(t);   RESC(); ROT();
    STEP(pA0,pA1,pB0,pB1,t+1,(t+4<NT),(t+2<NT),(t+2<NT));     ENDW(t+1); RESC(); ROT();
  }
  STEP(pB0,pB1,pA0,pA1,NT-1,false,false,false); RESC();
  { float sacc=pB0[0]+pB0[1]; _Pragma("unroll") for(int r=2;r<16;++r)sacc+=pB0[r]; _Pragma("unroll") for(int r=0;r<16;++r)sacc+=pB1[r]; l_reg+=sacc;
    pw0=(u32x4){PKW(pB0,0),PKW(pB0,2),PKW(pB0,4),PKW(pB0,6)};pw1=(u32x4){PKW(pB0,8),PKW(pB0,10),PKW(pB0,12),PKW(pB0,14)};pw2=(u32x4){PKW(pB1,0),PKW(pB1,2),PKW(pB1,4),PKW(pB1,6)};pw3=(u32x4){PKW(pB1,8),PKW(pB1,10),PKW(pB1,12),PKW(pB1,14)};
    SBAR(); pv(o,vb0+sl_cur,PAF(0),PAF(1),PAF(2),PAF(3)); }
  #undef PKW
  #undef PAF
  #undef VFR
  #undef PIN
  #undef MX3
  #undef GAPA
  #undef GAPB
  #undef EX
  #undef VRD
  #undef KRD
  #undef STEP
  #undef ENDW
  {auto rr=__builtin_amdgcn_permlane32_swap(__float_as_uint(l_reg),__float_as_uint(l_reg),false,false);l_reg=__uint_as_float(rr[0])+__uint_as_float(rr[1]);}
  if(hi==0)wsf[32+r32]=l_reg;asm volatile("s_waitcnt lgkmcnt(0)":::"memory");
  float rli[16];
  #pragma unroll
  for(int r=0;r<16;++r)rli[r]=__builtin_amdgcn_rcpf(wsf[32+crow(r,hi)]);
  bf16*Ow=O+(rowbase+q0+wid*QBLK)*DMO+h*D;
  const bf16*Gw=OG+(rowbase+q0+wid*QBLK)*DM+h*D;
  { bf16*stg=(bf16*)(shm+LDS_OST)+wid*2048;
    #pragma unroll
    for(int r=0;r<16;++r){const int orow=crow(r,hi);
      #pragma unroll
      for(int d0=0;d0<2;++d0)stg[orow*64+d0*32+r32]=__float2bfloat16(o[d0][r]*rli[r]);}
    asm volatile("s_waitcnt lgkmcnt(0)":::"memory");
    const int ch=lane&7; float gov[8];
    #pragma unroll
    for(int j=0;j<8;++j)gov[j]=GO[ch*8+j];
    #pragma unroll
    for(int i=0;i<4;++i){const int row=i*8+(lane>>3); const u32x4 v=*(const u32x4*)(stg+row*64+ch*8); const u32x4 gq=*(const u32x4*)(Gw+(long)row*DM+ch*8);
      float x[8],gg[8];
      #pragma unroll
      for(int j=0;j<4;++j){x[2*j]=__uint_as_float(v[j]<<16);x[2*j+1]=__uint_as_float(v[j]&0xffff0000u);gg[2*j]=__uint_as_float(gq[j]<<16);gg[2*j+1]=__uint_as_float(gq[j]&0xffff0000u);}
      float ss=0.f;
      #pragma unroll
      for(int j=0;j<8;++j)ss+=x[j]*x[j];
      ss+=__shfl_xor(ss,1);ss+=__shfl_xor(ss,2);ss+=__shfl_xor(ss,4);
      const float rs=__builtin_amdgcn_rsqf(ss*(1.0f/64.0f)+1e-6f);
      float y[8];
      #pragma unroll
      for(int j=0;j<8;++j)y[j]=x[j]*rs*gov[j]*__builtin_amdgcn_rcpf(1.0f+__builtin_amdgcn_exp2f(-1.4426950408889634f*gg[j]));
      u32x4 w; w[0]=cvtpk_s(y[0],y[1]);w[1]=cvtpk_s(y[2],y[3]);w[2]=cvtpk_s(y[4],y[5]);w[3]=cvtpk_s(y[6],y[7]);
      ATTN_STORE16(Ow+(long)row*DMO+ch*8,w);} }
  asm volatile("s_waitcnt lgkmcnt(0)\n\ts_barrier":::"memory");
  #undef DMA_K
  #undef DMA_V
  #undef CMASK
  #undef START
  #undef RESC
  #undef ROT
}
constexpr int ATTN_LDS_BYTES=LDS_BYTES;
#undef SBAR
#undef WAIT_BAR
}
constexpr int NWAVES = 8;
constexpr int BATCH = 32, SEQ = 2048, D = 1024, T = BATCH * SEQ;
constexpr int NP = 3840, D_IN = 3848;
constexpr int NE = 32, TOPK = 4, DE = 1024;
constexpr int CAP = T * TOPK + NE * 256;
constexpr int NLORA = 1536, KLORA = 256;
constexpr float LOG2E = 1.4426950408889634f;
constexpr float H2_SCALE = 32.0f, ACT_SCALE = 4.0f, W_SCALE = 256.0f, YS_SCALE = 64.0f;
constexpr int N_PHASES = 12;
#ifndef MK_N_LAUNCHES
#define MK_N_LAUNCHES 1
#endif

constexpr size_t MiB = 1u << 20;
constexpr size_t WS_CTL = 0, CTL_ZERO_BYTES = 1 * MiB;
constexpr size_t WS_MOD = 1 * MiB, WS_LF = 2 * MiB, WS_FB = 4 * MiB, WS_IDX = 6 * MiB, WS_GATE = 7 * MiB, WS_POS = 8 * MiB, WS_STOK = 9 * MiB;
constexpr size_t WS_WLORA = 11 * MiB, WS_WR = 11 * MiB + 768 * 1024, WS_WOUT = 12 * MiB, WS_WIN = 14 * MiB;
constexpr size_t WS_WGU = 32 * MiB, WS_WD = 96 * MiB;
constexpr size_t WS_LORA = 128 * MiB;
#ifndef P2F8
#define P2F8 3
#endif
static_assert(P2F8 == 3 || P2F8 == 0, "the attention keys are head-normalised in the projection GEMM's epilogue: the split settings are no longer complete");
constexpr float H_SCALE = 32.0f;
constexpr size_t WS_WIN8 = 22 * MiB, WS_H8 = 128 * MiB;
constexpr size_t WS_H = 320 * MiB;
constexpr size_t WS_P = 448 * MiB;
constexpr size_t WS_ALORA = 928 * MiB;
constexpr size_t WS_H2 = 128 * MiB, WS_ACT = 192 * MiB, WS_YS = 456 * MiB, WS_X1 = 720 * MiB, WS_END = 984 * MiB;
static_assert(WS_WGU + (size_t)NE * 2 * DE * D <= WS_WD && WS_WD + (size_t)NE * DE * D <= WS_H2 && WS_H2 + (size_t)T * D <= WS_ACT && WS_ACT + (size_t)CAP * DE <= WS_YS && WS_YS + (size_t)CAP * D <= WS_X1 && WS_X1 + (size_t)T * D * 2 <= WS_END, "ws map");
static_assert(WS_LORA + (size_t)T * 1536 * 2 <= WS_H && WS_H + (size_t)T * D * 2 <= WS_P && WS_P + (size_t)T * NP * 2 <= WS_ALORA && WS_ALORA + (size_t)T * 256 * 2 <= WS_END, "ws map (first half of the forward)");
constexpr int CW_BAR = 4096;
constexpr int CW_CNT = 256;
constexpr int CW_CUR = 320;

constexpr int RING_BYTES = 131072;
constexpr int AUX_OFF = RING_BYTES, AUX_BYTES = 30720;
constexpr int ROWTAB_UNITS = 40;
constexpr int BLK2E_OFF = AUX_OFF + ROWTAB_UNITS * 512, BLKVALID_OFF = BLK2E_OFF + 1152;
constexpr int LDSCTL_OFF = AUX_OFF + AUX_BYTES, MISC_OFF = LDSCTL_OFF + 256;
constexpr int LDS_BYTES = 163840;
static_assert(BLKVALID_OFF + 1152 * 2 <= LDSCTL_OFF && MISC_OFF + 256 <= LDS_BYTES && CAP / 256 <= 1152, "LDS map");

#define GAS __attribute__((address_space(1)))
#define LAS __attribute__((address_space(3)))
typedef unsigned short bf16;
typedef unsigned v4u __attribute__((ext_vector_type(4)));
typedef unsigned v2u __attribute__((ext_vector_type(2)));
typedef float f32x4 __attribute__((ext_vector_type(4)));
typedef float f32x2 __attribute__((ext_vector_type(2)));
#define LDS_WAIT() asm volatile("s_waitcnt lgkmcnt(0)" ::: "memory")
#define LDS_BARRIER() asm volatile("s_waitcnt lgkmcnt(0)\n\ts_barrier" ::: "memory")
__device__ __forceinline__ unsigned f2bf(float f) { unsigned u = __builtin_bit_cast(unsigned, f); return (u + 0x7fffu + ((u >> 16) & 1u)) >> 16; }
__device__ __forceinline__ unsigned pk2(float lo, float hi) { return f2bf(lo) | (f2bf(hi) << 16); }
__device__ __forceinline__ float bflo(unsigned w) { return __uint_as_float(w << 16); }
__device__ __forceinline__ float bfhi(unsigned w) { return __uint_as_float(w & 0xffff0000u); }
__device__ __forceinline__ float sigmoidf_(float x) { return 1.0f / (1.0f + __expf(-x)); }

#define XB_TMO      128
#define XB_XCNT(j)  (256  + 64 * (j))
#define XB_XSUB(j)  (1280 + 64 * (j))
#define XB_XGEN(j)  (2304 + 64 * (j))
#define XB_TOP      3328
#define XB_TOPGEN   3392
#define XCD_BAR_WORDS 3456
#define XB_SPIN_CAP (1u << 22)
__device__ __forceinline__ unsigned xb_ld(unsigned* p)              { return __hip_atomic_load(p, __ATOMIC_RELAXED, __HIP_MEMORY_SCOPE_AGENT); }
__device__ __forceinline__ unsigned xb_add(unsigned* p, unsigned v) { return __hip_atomic_fetch_add(p, v, __ATOMIC_RELAXED, __HIP_MEMORY_SCOPE_AGENT); }
__device__ __forceinline__ unsigned xb_xcc_id() { return (unsigned)__builtin_amdgcn_s_getreg((3 << 11) | 20) & 0xFu; }
#define XB_SPIN(cond, bar) do { unsigned _sp = 0; while (cond) { __builtin_amdgcn_s_sleep(1); \
    if ((++_sp & 255u) == 0u) { if (xb_ld(&(bar)[XB_TMO])) break; if (_sp > XB_SPIN_CAP) { atomicAdd(&(bar)[XB_TMO], 1u); break; } } } } while (0)
struct XcdBarrier { unsigned* bar; unsigned x; volatile LAS unsigned* st; };
__device__ __forceinline__ XcdBarrier xcd_barrier_post(unsigned* bar, volatile LAS unsigned* st, const int tid) {
    XcdBarrier b; b.bar = bar; b.x = xb_xcc_id(); b.st = st;
    if (tid == 0) (void)xb_add(&bar[XB_XCNT(b.x)], 1u);
    return b;
}
__device__ __forceinline__ void xcd_barrier_complete(unsigned* bar, unsigned x, unsigned& nloc, unsigned& nx) {
    const unsigned G = gridDim.x * gridDim.y * gridDim.z;
    unsigned sum, cnt, mine, sp = 0u;
    for (;;) {
        sum = 0u; cnt = 0u; mine = 0u;
#pragma unroll
        for (unsigned j = 0; j < 16; ++j) { const unsigned c = xb_ld(&bar[XB_XCNT(j)]); sum += c; cnt += (c > 0u) ? 1u : 0u; mine = (j == x) ? c : mine; }
        if (sum == G) break;
        __builtin_amdgcn_s_sleep(1);
        if ((++sp & 255u) == 0u) { if (xb_ld(&bar[XB_TMO])) break; if (sp > XB_SPIN_CAP) { atomicAdd(&bar[XB_TMO], 1u); break; } }
    }
    nloc = mine > 0u ? mine : 1u; nx = cnt > 0u ? cnt : 1u;
}
__device__ __forceinline__ void xcd_barrier(const XcdBarrier& b, const int tid) {
    asm volatile("s_waitcnt vmcnt(0)" ::: "memory");
    __syncthreads();
    if (tid == 0) {
        unsigned* bar = b.bar;
        __builtin_amdgcn_s_waitcnt(0);
        unsigned nloc = b.st[0], nx = b.st[1];
        if (nloc == 0u) { xcd_barrier_complete(bar, b.x, nloc, nx); b.st[0] = nloc; b.st[1] = nx; }
        const unsigned old = xb_add(&bar[XB_XSUB(b.x)], 1u);
        const unsigned gen = old / nloc;
        if (old + 1u == (gen + 1u) * nloc) {
            __builtin_amdgcn_fence(__ATOMIC_RELEASE, "agent");
            asm volatile("s_waitcnt vmcnt(0)" ::: "memory");
            const unsigned og = xb_add(&bar[XB_TOP], 1u);
            const unsigned tg = og / nx;
            if (og + 1u == (tg + 1u) * nx) xb_add(&bar[XB_TOPGEN], 1u);
            else XB_SPIN(xb_ld(&bar[XB_TOPGEN]) == tg, bar);
            __builtin_amdgcn_fence(__ATOMIC_ACQUIRE, "agent");
            xb_add(&bar[XB_XGEN(b.x)], 1u);
            asm volatile("s_waitcnt vmcnt(0)" ::: "memory");
        } else {
            XB_SPIN(xb_ld(&bar[XB_XGEN(b.x)]) == gen, bar);
            __builtin_amdgcn_fence(__ATOMIC_ACQUIRE, "agent");
            asm volatile("s_waitcnt vmcnt(0)" ::: "memory");
        }
    }
    __syncthreads();
}

typedef const float* cfp_t;
typedef __attribute__((address_space(4))) const cfp_t* in_tab_t;
#define LAUNDER(F) do { asm volatile("s_mov_b32 %0, 0" : "=s"((F).z)); asm volatile("" : "+v"((F).tid)); (F).lane = (F).tid & 63; } while (0)
struct Frame {
    LAS unsigned char* lds;
    volatile LAS unsigned* MISC;
    unsigned* ctl;
    int tid, lane, wave, vcu, G, z;
    in_tab_t in; float* out; unsigned char* ws;
};
#define DPP_F(x, ctrl) __uint_as_float(__builtin_amdgcn_update_dpp(0, __float_as_uint(x), (ctrl), 0xF, 0xF, true))
__device__ __forceinline__ float wave_sum(float v) {
    v += DPP_F(v, 0xB1); v += DPP_F(v, 0x4E); v += DPP_F(v, 0x141); v += DPP_F(v, 0x140);
    { auto rr = __builtin_amdgcn_permlane16_swap(__float_as_uint(v), __float_as_uint(v), false, false); v = __uint_as_float(rr[0]) + __uint_as_float(rr[1]); }
    { auto rr = __builtin_amdgcn_permlane32_swap(__float_as_uint(v), __float_as_uint(v), false, false); v = __uint_as_float(rr[0]) + __uint_as_float(rr[1]); }
    return v;
}
__device__ __forceinline__ float half_max(float v) {
    v = fmaxf(v, DPP_F(v, 0xB1)); v = fmaxf(v, DPP_F(v, 0x4E)); v = fmaxf(v, DPP_F(v, 0x141)); v = fmaxf(v, DPP_F(v, 0x140));
    { auto rr = __builtin_amdgcn_permlane16_swap(__float_as_uint(v), __float_as_uint(v), false, false); v = fmaxf(__uint_as_float(rr[0]), __uint_as_float(rr[1])); }
    return v;
}
__device__ __forceinline__ float sum8(float v) { v += DPP_F(v, 0xB1); v += DPP_F(v, 0x4E); v += DPP_F(v, 0x141); return v; }

__device__ __forceinline__ void tr_item(const float* W, int ldw, int k0, int n0, bf16* WT, int ldo, int orow0, LAS float* scr, int lane) {
    float t_[32];
#pragma unroll
    for (int i = 0; i < 32; ++i) t_[i] = W[(size_t)(k0 + 2 * i + (lane >> 5)) * ldw + n0 + (lane & 31)];
#pragma unroll
    for (int i = 0; i < 32; ++i) scr[(2 * i + (lane >> 5)) * 33 + (lane & 31)] = t_[i];
    LDS_WAIT(); asm volatile("" ::: "memory");
    const int c = lane & 7;
#pragma unroll
    for (int j = 0; j < 4; ++j) { const int n = (lane >> 3) + 8 * j; const LAS float* s = scr + (8 * c) * 33 + n;
        v4u o; o.x = pk2(s[0 * 33], s[1 * 33]); o.y = pk2(s[2 * 33], s[3 * 33]); o.z = pk2(s[4 * 33], s[5 * 33]); o.w = pk2(s[6 * 33], s[7 * 33]);
        *(GAS v4u*)(WT + (size_t)(orow0 + n) * ldo + k0 + 8 * c) = o; }
    LDS_WAIT(); asm volatile("" ::: "memory");
}

__device__ __forceinline__ void tr_item_fp8(const float* W, int ldw, int k0, int n0, unsigned char* WT, int ldo, int orow0, LAS float* scr, int lane, float scale) {
    float t_[32];
#pragma unroll
    for (int i = 0; i < 32; ++i) t_[i] = W[(size_t)(k0 + 2 * i + (lane >> 5)) * ldw + n0 + (lane & 31)];
#pragma unroll
    for (int i = 0; i < 32; ++i) scr[(2 * i + (lane >> 5)) * 33 + (lane & 31)] = t_[i] * scale;
    LDS_WAIT(); asm volatile("" ::: "memory");
    const int c = lane & 7;
#pragma unroll
    for (int j = 0; j < 4; ++j) { const int n = (lane >> 3) + 8 * j; const LAS float* s = scr + (8 * c) * 33 + n;
        v2u o; o.x = pg8::pk4_fp8(s[0 * 33], s[1 * 33], s[2 * 33], s[3 * 33]); o.y = pg8::pk4_fp8(s[4 * 33], s[5 * 33], s[6 * 33], s[7 * 33]);
        *(GAS v2u*)(WT + (size_t)(orow0 + n) * ldo + k0 + 8 * c) = o; }
    LDS_WAIT(); asm volatile("" ::: "memory");
}

struct TrItem { const float* src; unsigned char* dst; int ldw; };
__device__ __forceinline__ void tr_issue(const TrItem& c, float (&t)[32], int lane) {
    const float* s = c.src + (size_t)(lane >> 5) * c.ldw + (lane & 31);
#pragma unroll
    for (int i = 0; i < 32; ++i) t[i] = s[(size_t)(2 * i) * c.ldw];
    asm volatile("" ::: "memory");
}
__device__ __forceinline__ void tr_finish(const TrItem& c, const float (&t)[32], LAS float* scr, int lane, float scale) {
#pragma unroll
    for (int i = 0; i < 32; ++i) scr[(2 * i + (lane >> 5)) * 33 + (lane & 31)] = t[i] * scale;
    LDS_WAIT(); asm volatile("" ::: "memory");
    const int cc = lane & 7;
#pragma unroll
    for (int j = 0; j < 4; ++j) { const int n = (lane >> 3) + 8 * j; const LAS float* s = scr + (8 * cc) * 33 + n;
        v2u o; o.x = pg8::pk4_fp8(s[0 * 33], s[1 * 33], s[2 * 33], s[3 * 33]); o.y = pg8::pk4_fp8(s[4 * 33], s[5 * 33], s[6 * 33], s[7 * 33]);
        *(GAS v2u*)(c.dst + (size_t)n * 1024 + 8 * cc) = o; }
    LDS_WAIT(); asm volatile("" ::: "memory");
}
__device__ __forceinline__ void tr_dma_issue(const TrItem& c, LAS unsigned char* buf, int lane) {
    const char* s = (const char*)c.src + ((size_t)(lane >> 3) * c.ldw + 4 * (lane & 7)) * 4;
    const size_t rs = (size_t)c.ldw * 32;
#pragma unroll
    for (int i = 0; i < 8; ++i) __builtin_amdgcn_global_load_lds((const unsigned*)(s + i * rs), (LAS unsigned*)(buf + i * 1056), 16, 0, 0);
}
__device__ __forceinline__ void tr_dma_finish(const TrItem& c, const LAS unsigned char* buf, int lane, float scale) {
    const int cc = lane & 7;
#pragma unroll
    for (int j = 0; j < 4; ++j) { const int n = (lane >> 3) + 8 * j; const LAS float* s = (const LAS float*)(buf + cc * 1056) + n;
        v2u o; o.x = pg8::pk4_fp8(s[0] * scale, s[32] * scale, s[64] * scale, s[96] * scale); o.y = pg8::pk4_fp8(s[128] * scale, s[160] * scale, s[192] * scale, s[224] * scale);
        *(GAS v2u*)(c.dst + (size_t)n * 1024 + 8 * cc) = o; }
    LDS_WAIT();
}
__device__ __forceinline__ TrItem moe_tr_item(Frame& F, int it) {
    constexpr int I_GU = 32 * 16 * 64; TrItem c;
    if (it < I_GU) { const int e = it >> 10, r = it & 1023, kb = r >> 6, nb = r & 63, n0 = 32 * nb; const int n1 = n0 & 1023;
        const int orow = 256 * (n1 >> 7) + (n0 >= 1024 ? 128 : 0) + (n1 & 127);
        c.src = F.in[25 + F.z] + (size_t)e * 1024 * 2048 + (size_t)(64 * kb) * 2048 + n0; c.dst = (unsigned char*)(F.ws + WS_WGU) + (size_t)e * 2048 * 1024 + (size_t)orow * 1024 + 64 * kb; c.ldw = 2048; }
    else { const int q = it - I_GU, e = q >> 9, r = q & 511, kb = r >> 5, nb = r & 31;
        c.src = F.in[27 + F.z] + (size_t)e * 1024 * 1024 + (size_t)(64 * kb) * 1024 + 32 * nb; c.dst = (unsigned char*)(F.ws + WS_WD) + (size_t)e * 1024 * 1024 + (size_t)(32 * nb) * 1024 + 64 * kb; c.ldw = 1024; }
    return c;
}

__device__ __forceinline__ void p0_prologue(Frame& F) {
    const float* c = F.in[1 + F.z]; const float* w_ada = F.in[2 + F.z]; const float* b_ada = F.in[3 + F.z];
    float* mod = (float*)(F.ws + WS_MOD);
    LAS float* cact = (LAS float*)F.lds;
    for (int cg = F.vcu; cg < 96; cg += F.G) {
        for (int idx = F.tid; idx < 32768; idx += NWAVES * 64) { const int b = idx >> 10, k = idx & 1023; const float v = c[idx]; cact[k * 32 + b] = v / (1.0f + __expf(-v)); }
        __syncthreads();
        float acc[32];
#pragma unroll
        for (int b = 0; b < 32; ++b) acc[b] = 0.f;
        const int col = cg * 64 + F.lane;
        for (int kb = F.wave * 128; kb < F.wave * 128 + 128; kb += 16) {
            float wv[16];
#pragma unroll
            for (int u = 0; u < 16; ++u) wv[u] = w_ada[(size_t)(kb + u) * 6144 + col];
#pragma unroll
            for (int u = 0; u < 16; ++u)
#pragma unroll
                for (int q = 0; q < 8; ++q) { const f32x4 cv = *(const LAS f32x4*)(cact + (kb + u) * 32 + 4 * q);
                    acc[4 * q + 0] += cv[0] * wv[u]; acc[4 * q + 1] += cv[1] * wv[u]; acc[4 * q + 2] += cv[2] * wv[u]; acc[4 * q + 3] += cv[3] * wv[u]; }
        }
        __syncthreads();
        LAS float* red = (LAS float*)F.lds;
#pragma unroll
        for (int b = 0; b < 32; ++b) red[(F.wave * 32 + b) * 64 + F.lane] = acc[b];
        __syncthreads();
        for (int idx = F.tid; idx < 2048; idx += NWAVES * 64) { const int b = idx >> 6, l = idx & 63; float s = b_ada[cg * 64 + l];
#pragma unroll
            for (int w = 0; w < 8; ++w) s += red[(w * 32 + b) * 64 + l];
            mod[(size_t)b * 6144 + cg * 64 + l] = s; }
        __syncthreads();
    }
    LAS float* scr = (LAS float*)(F.lds + F.wave * 16384);
    const int gw = F.vcu * NWAVES + F.wave, NGW = F.G * NWAVES;
    constexpr int I_IN = 16 * 120, I_OUT = 16 * 32;
    for (int it = gw; it < I_IN + I_OUT; it += NGW) {
        if (it < I_IN) { const int kb = it / 120, nb = it % 120;
            if (P2F8 != 3) { int orow = 32 * nb; if (orow >= 2304 && orow < 2816) { const int ct = (orow - 2304) & 255; orow = orow - ct + 128 * ((ct >> 5) & 1) + 32 * (ct >> 6); }
                tr_item(F.in[5 + F.z], D_IN, 64 * kb, 32 * nb, (bf16*)(F.ws + WS_WIN), D, orow, scr, F.lane); }
            if (P2F8 != 0) { int orow = 32 * nb;
                if (P2F8 == 3 && orow >= 2304 && orow < 2816) { const int ct = (orow - 2304) & 255; orow = orow - ct + 128 * ((ct >> 5) & 1) + 32 * (ct >> 6); }
                tr_item_fp8(F.in[5 + F.z], D_IN, 64 * kb, 32 * nb, (unsigned char*)(F.ws + WS_WIN8), D, orow, scr, F.lane, W_SCALE); } }
        else { const int r = it - I_IN, kb = r / 32, nb = r % 32; tr_item(F.in[21 + F.z], D, 64 * kb, 32 * nb, (bf16*)(F.ws + WS_WOUT), D, 32 * nb, scr, F.lane); }
    }
    { constexpr int I_GU = 32 * 16 * 64, I_DN = 32 * 16 * 32;
      const int n_modw = (F.G > 96 ? 96 : F.G) * NWAVES, n_othw = NGW - n_modw; const bool modw = F.vcu < 96;
      const int n_a = n_othw > 0 ? n_modw * 20 : I_GU + I_DN;
      const int it0 = modw ? gw : n_a + (gw - n_modw), it_end = modw ? n_a : I_GU + I_DN, it_step = modw ? n_modw : n_othw;
      __syncthreads();
      LAS unsigned char* bufA = F.lds + __builtin_amdgcn_readfirstlane(F.wave) * 16896; LAS unsigned char* bufB = bufA + 8448;
      TrItem ca, cb;
      if (it0 < it_end) {
          int it = it0; ca = moe_tr_item(F, it); tr_dma_issue(ca, bufA, F.lane);
          while (true) {
              const int i1 = it + it_step; const bool h1 = i1 < it_end;
              if (h1) { cb = moe_tr_item(F, i1); tr_dma_issue(cb, bufB, F.lane); asm volatile("s_waitcnt vmcnt(8)" ::: "memory"); }
              else asm volatile("s_waitcnt vmcnt(0)" ::: "memory");
              tr_dma_finish(ca, bufA, F.lane, W_SCALE);
              if (!h1) break;
              const int i2 = i1 + it_step; const bool h2 = i2 < it_end;
              if (h2) { ca = moe_tr_item(F, i2); tr_dma_issue(ca, bufA, F.lane); asm volatile("s_waitcnt vmcnt(8)" ::: "memory"); }
              else asm volatile("s_waitcnt vmcnt(0)" ::: "memory");
              tr_dma_finish(cb, bufB, F.lane, W_SCALE);
              if (!h2) break;
              it = i2;
          } } }
    { bf16* WR = (bf16*)(F.ws + WS_WR); const float* wr = F.in[23 + F.z];
      for (int idx = gw * 64 + F.lane; idx < 32 * 1024; idx += NGW * 64) { const int e = idx >> 10, k = idx & 1023; const float w = wr[k * 32 + e]; const unsigned hb = f2bf(w);
          WR[idx] = (bf16)hb; WR[32 * 1024 + idx] = (bf16)f2bf(w - __uint_as_float(hb << 16)); } }
    { bf16* WL = (bf16*)(F.ws + WS_WLORA); const float* w2 = F.in[8 + F.z]; const float* a2 = F.in[10 + F.z]; const float* g2 = F.in[11 + F.z];
      for (int idx = gw * 64 + F.lane; idx < NLORA * KLORA; idx += NGW * 64) { const int n = idx >> 8, k = idx & 255; float v = 0.f;
          if (n < 512) { if (k < 64) v = w2[k * 512 + n]; }
          else if (n < 1024) { if (k >= 64 && k < 128) v = a2[(k - 64) * 512 + (n - 512)]; }
          else { if (k >= 128) v = g2[(k - 128) * 512 + (n - 1024)]; }
          WL[idx] = (bf16)f2bf(v); } }
}

__device__ __forceinline__ void p1_norm1(Frame& F) {
    const float* x = F.in[0 + F.z]; const float* g1 = F.in[4 + F.z]; const float* w_in = F.in[5 + F.z]; const float* b_f = F.in[17 + F.z];
    const float* mod = (const float*)(F.ws + WS_MOD); bf16* h = (bf16*)(F.ws + WS_H); float* lf = (float*)(F.ws + WS_LF);
    LAS float* wf = (LAS float*)F.lds;
    for (int idx = F.tid; idx < 8192; idx += NWAVES * 64) wf[idx] = w_in[(size_t)(idx >> 3) * D_IN + NP + (idx & 7)];
    __syncthreads();
    const int gw = F.vcu * NWAVES + F.wave, NGW = F.G * NWAVES;
    for (int rg = gw; rg < T / 32; rg += NGW) {
        const int m0 = rg * 32, b = m0 / SEQ;
        f32x4 cA[4], cB[4];
#pragma unroll
        for (int j = 0; j < 4; ++j) { const int col = 4 * F.lane + 256 * j; const f32x4 g = *(const f32x4*)(g1 + col), sc = *(const f32x4*)(mod + (size_t)b * 6144 + 1024 + col);
            cA[j] = g * (sc + 1.0f); cB[j] = *(const f32x4*)(mod + (size_t)b * 6144 + col); }
        f32x4 nx[4], nx2[4];
        { const GAS f32x4* xr = (const GAS f32x4*)(x + (size_t)m0 * D) + F.lane;
#pragma unroll
          for (int j = 0; j < 4; ++j) { nx[j] = xr[64 * j]; nx2[j] = xr[256 + 64 * j]; } }
        for (int r = 0; r < 32; ++r) {
            const int m = m0 + r;
            f32x4 v[4]; float ss = 0.f;
#pragma unroll
            for (int j = 0; j < 4; ++j) { v[j] = nx[j]; nx[j] = nx2[j]; }
            if (r + 2 < 32) { const GAS f32x4* xr = (const GAS f32x4*)(x + (size_t)(m + 2) * D) + F.lane;
#pragma unroll
                for (int j = 0; j < 4; ++j) nx2[j] = xr[64 * j]; }
#pragma unroll
            for (int j = 0; j < 4; ++j) ss += (v[j].x * v[j].x + v[j].y * v[j].y) + (v[j].z * v[j].z + v[j].w * v[j].w);
            const float rstd = 1.0f / sqrtf(wave_sum(ss) * (1.0f / D) + 1e-6f);
            float fl[8];
#pragma unroll
            for (int q = 0; q < 8; ++q) fl[q] = 0.f;
            GAS v2u* o8 = (GAS v2u*)(h + (size_t)m * D) + F.lane;
#pragma unroll
            for (int j = 0; j < 4; ++j) { const f32x4 hv = v[j] * rstd * cA[j] + cB[j];
                if (P2F8 != 3) o8[64 * j] = (v2u){pk2(hv.x, hv.y), pk2(hv.z, hv.w)};
                if (P2F8 != 0) ((GAS unsigned*)((unsigned char*)(F.ws + WS_H8) + (size_t)m * D) + F.lane)[64 * j] = pg8::pk4_fp8(hv.x * H_SCALE, hv.y * H_SCALE, hv.z * H_SCALE, hv.w * H_SCALE);
#pragma unroll
                for (int i = 0; i < 4; ++i) { const LAS float* wp = wf + (4 * F.lane + 256 * j + i) * 8; const f32x4 w0 = *(const LAS f32x4*)wp, w1 = *(const LAS f32x4*)(wp + 4);
                    fl[0] += hv[i] * w0[0]; fl[1] += hv[i] * w0[1]; fl[2] += hv[i] * w0[2]; fl[3] += hv[i] * w0[3]; fl[4] += hv[i] * w1[0]; fl[5] += hv[i] * w1[1]; fl[6] += hv[i] * w1[2]; fl[7] += hv[i] * w1[3]; } }
            float mine = 0.f;
#pragma unroll
            for (int q = 0; q < 8; ++q) { const float s = wave_sum(fl[q]); if (F.lane == q) mine = s; }
            if (F.lane < 8) { const float z = mine + b_f[F.lane]; lf[(size_t)m * 8 + F.lane] = fminf(z, 0.f) - __logf(1.0f + __expf(-fabsf(z))); }
        }
    }
}

__device__ __forceinline__ void fox_bias_table(Frame& F, int bh, LAS float* tab, LAS float* wsum) {
    const float* lf = (const float*)(F.ws + WS_LF) + ((size_t)(bh >> 3) * SEQ + 4 * F.tid) * 8 + (bh & 7);
    float v[4]; float run = 0.f;
#pragma unroll
    for (int i = 0; i < 4; ++i) { run += lf[8 * i]; v[i] = run; }
    float incl = run;
#pragma unroll
    for (int o = 1; o < 64; o <<= 1) { const float t = __shfl_up(incl, o); if (F.lane >= o) incl += t; }
    if (F.lane == 63) wsum[F.wave] = incl;
    __syncthreads();
    float carry = 0.f;
    for (int w = 0; w < F.wave; ++w) carry += wsum[w];
    const float excl = carry + incl - run;
    *(LAS f32x4*)(tab + 4 * F.tid) = (f32x4){-(excl + v[0]) * LOG2E, -(excl + v[1]) * LOG2E, -(excl + v[2]) * LOG2E, -(excl + v[3]) * LOG2E};
}

__device__ __forceinline__ void p3_prep(Frame& F) {
    bf16* p = (bf16*)(F.ws + WS_P); bf16* alora = (bf16*)(F.ws + WS_ALORA);
    const float* mu = F.in[6 + F.z];
    const int gw = F.vcu * NWAVES + F.wave, NGW = F.G * NWAVES, lane = F.lane;
    float mu4[4];
#pragma unroll
    for (int i = 0; i < 4; ++i) mu4[i] = mu[1536 + 4 * lane + i];
    for (int rg = gw; rg < T / 32; rg += NGW) {
        const int m0 = rg * 32;
        float prev[4] = {0.f, 0.f, 0.f, 0.f};
        if ((m0 & (SEQ - 1)) != 0) { const v2u w = *(const GAS v2u*)(p + (size_t)(m0 - 1) * NP + 1536 + 4 * lane); prev[0] = bflo(w.x); prev[1] = bfhi(w.x); prev[2] = bflo(w.y); prev[3] = bfhi(w.y); }
        v2u nwq[8];
#pragma unroll
        for (int u = 0; u < 8; ++u) nwq[u] = *(const GAS v2u*)(p + (size_t)(m0 + u) * NP + 1536 + 4 * lane);
        for (int r0 = 0; r0 < 32; r0 += 8) {
#pragma unroll
          for (int u = 0; u < 8; ++u) {
            const int m = m0 + r0 + u;
            const v2u w = nwq[u];
            if (r0 + 8 < 32) nwq[u] = *(const GAS v2u*)(p + (size_t)(m + 8) * NP + 1536 + 4 * lane);
            float cur[4] = {bflo(w.x), bfhi(w.x), bflo(w.y), bfhi(w.y)}, a[4];
#pragma unroll
            for (int i = 0; i < 4; ++i) { const float xs = cur[i] + mu4[i] * (prev[i] - cur[i]); prev[i] = cur[i];
                const float ex = __expf(lane < 16 ? -2.0f * xs : -xs), rc = __builtin_amdgcn_rcpf(1.0f + ex);
                a[i] = lane < 16 ? 2.0f * rc - 1.0f : (lane < 32 ? xs : rc); }
            *(GAS v2u*)(alora + (size_t)m * KLORA + 4 * lane) = (v2u){pk2(a[0], a[1]), pk2(a[2], a[3])};
          }
        }
    }
}
__device__ __forceinline__ float red8_dpp(float x) { x += DPP_F(x, 0xB1); x += DPP_F(x, 0x4E); x += DPP_F(x, 0x141); return x; }

constexpr int RW_CH = 32, RW_ARR = RW_CH * 64, RW_BUF = 6 * RW_ARR, RW_Y = 2 * RW_BUF, RW_CST = RW_Y + 2 * RW_ARR;
constexpr int RW_D = 0, RW_NK = RW_ARR, RW_KA = 2 * RW_ARR, RW_KF = 3 * RW_ARR, RW_R = 4 * RW_ARR, RW_V = 5 * RW_ARR;
struct RwOps { f32x2 d[4], nk[4], ka[4], kf[4], r[4]; f32x2 v; };
__device__ __forceinline__ void rw_load(RwOps& o, const LAS float* buf, int i, int k0, int row0) {
    const LAS float* q = buf + i * 64 + k0;
#define RW_LD(dst, off) do { const f32x4 a_ = *(const LAS f32x4*)(q + (off)), b_ = *(const LAS f32x4*)(q + (off) + 4); dst[0] = (f32x2){a_[0], a_[1]}; dst[1] = (f32x2){a_[2], a_[3]}; dst[2] = (f32x2){b_[0], b_[1]}; dst[3] = (f32x2){b_[2], b_[3]}; } while (0)
    RW_LD(o.d, RW_D); RW_LD(o.nk, RW_NK); RW_LD(o.ka, RW_KA); RW_LD(o.kf, RW_KF); RW_LD(o.r, RW_R);
#undef RW_LD
    o.v = *(const LAS f32x2*)(buf + RW_V + i * 64 + row0);
}
__device__ __forceinline__ void rw_step(f32x2 (&s0)[4], f32x2 (&s1)[4], const RwOps& o, LAS float* ybuf, int i, int row0, bool writer) {
    f32x2 a0 = s0[0] * o.nk[0], a1 = s1[0] * o.nk[0];
#pragma unroll
    for (int q = 1; q < 4; ++q) { a0 += s0[q] * o.nk[q]; a1 += s1[q] * o.nk[q]; }
    const float sa0 = red8_dpp(a0.x + a0.y), sa1 = red8_dpp(a1.x + a1.y);
    const f32x2 sa0v = {sa0, sa0}, sa1v = {sa1, sa1}, v0 = {o.v.x, o.v.x}, v1 = {o.v.y, o.v.y};
#pragma unroll
    for (int q = 0; q < 4; ++q) { s0[q] = s0[q] * o.d[q] + (sa0v * o.ka[q] + v0 * o.kf[q]); s1[q] = s1[q] * o.d[q] + (sa1v * o.ka[q] + v1 * o.kf[q]); }
    f32x2 y0 = s0[0] * o.r[0], y1 = s1[0] * o.r[0];
#pragma unroll
    for (int q = 1; q < 4; ++q) { y0 += s0[q] * o.r[q]; y1 += s1[q] * o.r[q]; }
    const float yy0 = red8_dpp(y0.x + y0.y), yy1 = red8_dpp(y1.x + y1.y);
    if (writer) *(LAS f32x2*)(ybuf + i * 64 + row0) = (f32x2){yy0, yy1};
}
struct RwRaw { v4u rw, kw, vw, rwp, kwp, vwp, lw, la; };
__device__ __forceinline__ void rw_fetch(RwRaw& x, const bf16* p, const bf16* lo, size_t m, int t, int h, int c0) {
    const bf16* pr = p + m * NP + h * 64 + c0;
    x.rw = *(const GAS v4u*)(pr); x.kw = *(const GAS v4u*)(pr + 512); x.vw = *(const GAS v4u*)(pr + 1024);
    x.rwp = (v4u){0u, 0u, 0u, 0u}; x.kwp = x.rwp; x.vwp = x.rwp;
    if (t > 0) { x.rwp = *(const GAS v4u*)(pr - NP); x.kwp = *(const GAS v4u*)(pr - NP + 512); x.vwp = *(const GAS v4u*)(pr - NP + 1024); }
    x.lw = *(const GAS v4u*)(lo + m * NLORA + h * 64 + c0); x.la = *(const GAS v4u*)(lo + m * NLORA + 512 + h * 64 + c0);
}
__device__ __forceinline__ void rw_prep(const RwRaw& x, LAS float* L, LAS float* buf, int ti, int c0) {
    float rr[8], kk[8], vv[8], dd[8], aa[8], kn[8]; float ss = 0.f;
#pragma unroll
    for (int j = 0; j < 8; ++j) {
        const int c = c0 + j;
#define BFJ(w) __uint_as_float(((j & 1) ? (w[j >> 1] & 0xffff0000u) : (w[j >> 1] << 16)))
        const float rc = BFJ(x.rw), kc = BFJ(x.kw), vc = BFJ(x.vw), rpv = BFJ(x.rwp), kpv = BFJ(x.kwp), vpv = BFJ(x.vwp), lwv = BFJ(x.lw), lav = BFJ(x.la);
#undef BFJ
        rr[j] = rc + L[RW_CST + 0 * 64 + c] * (rpv - rc); kk[j] = kc + L[RW_CST + 1 * 64 + c] * (kpv - kc); vv[j] = vc + L[RW_CST + 2 * 64 + c] * (vpv - vc);
        const float z = -(L[RW_CST + 3 * 64 + c] + lwv);
        const float w = -(fmaxf(z, 0.f) + __logf(1.0f + __expf(-fabsf(z)))) - 0.5f;
        dd[j] = __expf(-__expf(w));
        aa[j] = __builtin_amdgcn_rcpf(1.0f + __expf(-(L[RW_CST + 4 * 64 + c] + lav)));
        kn[j] = kk[j] * L[RW_CST + 5 * 64 + c]; ss += kn[j] * kn[j];
    }
    ss = sum8(ss);
    const float inv = __builtin_amdgcn_rsqf(fmaxf(ss, 1e-24f));
    float o_nk[8], o_ka[8], o_kf[8];
#pragma unroll
    for (int j = 0; j < 8; ++j) { const float kkn = kn[j] * inv; o_nk[j] = -kkn; o_ka[j] = kkn * aa[j]; o_kf[j] = kk[j] * (1.0f + (aa[j] - 1.0f) * L[RW_CST + 6 * 64 + c0 + j]); }
    LAS float* q = buf + ti * 64 + c0;
#define RW_ST(off, a) do { *(LAS f32x4*)(q + (off)) = (f32x4){a[0], a[1], a[2], a[3]}; *(LAS f32x4*)(q + (off) + 4) = (f32x4){a[4], a[5], a[6], a[7]}; } while (0)
    RW_ST(RW_D, dd); RW_ST(RW_NK, o_nk); RW_ST(RW_KA, o_ka); RW_ST(RW_KF, o_kf); RW_ST(RW_R, rr); RW_ST(RW_V, vv);
#undef RW_ST
}
__device__ __forceinline__ void rw_epi(const LAS float* L, const LAS float* buf, const LAS float* ybuf, int ti, int c0, const bf16* lo, bf16* ymix, size_t m, int h) {
    const LAS float* q = buf + ti * 64 + c0; const LAS float* qy = ybuf + ti * 64 + c0;
    float y[8], r8[8], kf8[8], v8[8];
#define RW_LD8(dst, ptr) do { const f32x4 a_ = *(const LAS f32x4*)(ptr), b_ = *(const LAS f32x4*)((ptr) + 4); dst[0] = a_[0]; dst[1] = a_[1]; dst[2] = a_[2]; dst[3] = a_[3]; dst[4] = b_[0]; dst[5] = b_[1]; dst[6] = b_[2]; dst[7] = b_[3]; } while (0)
    RW_LD8(y, qy); RW_LD8(r8, q + RW_R); RW_LD8(kf8, q + RW_KF); RW_LD8(v8, q + RW_V);
#undef RW_LD8
    const v4u gw = *(const GAS v4u*)(lo + m * NLORA + 1024 + h * 64 + c0);
    float sm = 0.f, bs = 0.f;
#pragma unroll
    for (int j = 0; j < 8; ++j) { sm += y[j]; bs += r8[j] * kf8[j] * L[RW_CST + 7 * 64 + c0 + j]; }
    sm = sum8(sm); bs = sum8(bs);
    const float mean = sm * (1.0f / 64.0f); float vs = 0.f;
#pragma unroll
    for (int j = 0; j < 8; ++j) { const float dlt = y[j] - mean; vs += dlt * dlt; }
    vs = sum8(vs);
    const float rstd = __builtin_amdgcn_rsqf(vs * (1.0f / 64.0f) + 64e-5f);
    float o[8];
#pragma unroll
    for (int j = 0; j < 8; ++j) { const float g = (j & 1) ? bfhi(gw[j >> 1]) : bflo(gw[j >> 1]);
        o[j] = ((y[j] - mean) * rstd * L[RW_CST + 8 * 64 + c0 + j] + L[RW_CST + 9 * 64 + c0 + j] + bs * v8[j]) * g; }
    *(GAS v4u*)(ymix + m * D + h * 64 + c0) = (v4u){pk2(o[0], o[1]), pk2(o[2], o[3]), pk2(o[4], o[5]), pk2(o[6], o[7])};
}
__device__ __forceinline__ void rwkv_unit(Frame& F, int bh) {
    const int b = bh >> 3, h = bh & 7, tid = F.tid, lane = F.lane;
    const bf16* p = (const bf16*)(F.ws + WS_P); const bf16* lo = (const bf16*)(F.ws + WS_LORA); bf16* ymix = (bf16*)(F.ws + WS_H);
    LAS float* L = (LAS float*)F.lds;
    __syncthreads();
    if (tid < 64) { const int c = h * 64 + tid; const float* mu = F.in[6 + F.z];
        L[RW_CST + 0 * 64 + tid] = mu[c]; L[RW_CST + 1 * 64 + tid] = mu[512 + c]; L[RW_CST + 2 * 64 + tid] = mu[1024 + c];
        L[RW_CST + 3 * 64 + tid] = F.in[7 + F.z][c]; L[RW_CST + 4 * 64 + tid] = F.in[9 + F.z][c]; L[RW_CST + 5 * 64 + tid] = F.in[12 + F.z][c]; L[RW_CST + 6 * 64 + tid] = F.in[13 + F.z][c];
        L[RW_CST + 7 * 64 + tid] = F.in[14 + F.z][c]; L[RW_CST + 8 * 64 + tid] = F.in[15 + F.z][c]; L[RW_CST + 9 * 64 + tid] = F.in[16 + F.z][c]; }
    __syncthreads();
    const bool scanner = F.wave < 4;
    const int pt = tid & 255, ti = pt >> 3, c0 = (pt & 7) * 8;
    const int rp = lane >> 3, k0 = (lane & 7) * 8, row0 = 16 * (F.wave & 3) + 2 * rp;
    const size_t mb = (size_t)b * SEQ;
    constexpr int NCH = SEQ / RW_CH;
    f32x2 s0[4], s1[4];
#pragma unroll
    for (int q = 0; q < 4; ++q) { s0[q] = (f32x2){0.f, 0.f}; s1[q] = (f32x2){0.f, 0.f}; }
    if (!scanner) { RwRaw x; rw_fetch(x, p, lo, mb + ti, ti, h, c0); rw_prep(x, L, L, ti, c0); }
    __syncthreads();
    for (int ch = 0; ch < NCH; ++ch) {
        LAS float* bufc = L + (ch & 1) * RW_BUF; LAS float* bufn = L + ((ch + 1) & 1) * RW_BUF;
        LAS float* yc = L + RW_Y + (ch & 1) * RW_ARR; LAS float* yp = L + RW_Y + ((ch + 1) & 1) * RW_ARR;
        if (scanner) {
            RwOps A, B;
            rw_load(A, bufc, 0, k0, row0);
            for (int i = 0; i < RW_CH; i += 2) {
                rw_load(B, bufc, i + 1, k0, row0);
                rw_step(s0, s1, A, yc, i, row0, (lane & 7) == 0);
                if (i + 2 < RW_CH) rw_load(A, bufc, i + 2, k0, row0);
                rw_step(s0, s1, B, yc, i + 1, row0, (lane & 7) == 0);
            }
        } else {
            RwRaw x; const int tn = (ch + 1) * RW_CH + ti;
            if (ch + 1 < NCH) rw_fetch(x, p, lo, mb + tn, tn, h, c0);
            if (ch > 0) rw_epi(L, bufn, yp, ti, c0, lo, ymix, mb + (ch - 1) * RW_CH + ti, h);
            if (ch + 1 < NCH) rw_prep(x, L, bufn, ti, c0);
        }
        __syncthreads();
    }
    if (!scanner) rw_epi(L, L + ((NCH - 1) & 1) * RW_BUF, L + RW_Y + ((NCH - 1) & 1) * RW_ARR, ti, c0, lo, ymix, mb + (NCH - 1) * RW_CH + ti, h);
    __syncthreads();
}

struct ConvItem { const float* src; unsigned char* dst; };
__device__ __forceinline__ ConvItem conv_item(Frame& F, int it) {
    constexpr int I_GU = 32 * 16 * 64; ConvItem c;
    if (it < I_GU) { const int e = it >> 10, r = it & 1023, kb = r >> 6, nb = r & 63, n0 = 32 * nb; const int n1 = n0 & 1023;
        const int orow = 256 * (n1 >> 7) + (n0 >= 1024 ? 128 : 0) + (n1 & 127);
        c.src = F.in[25 + F.z] + (size_t)e * 1024 * 2048 + (size_t)(64 * kb) * 2048 + n0; c.dst = (unsigned char*)(F.ws + WS_WGU) + (size_t)e * 2048 * 1024 + (size_t)orow * 1024 + 64 * kb; }
    else { const int q = it - I_GU, e = q >> 9, r = q & 511, kb = r >> 5, nb = r & 31;
        c.src = F.in[27 + F.z] + (size_t)e * 1024 * 1024 + (size_t)(64 * kb) * 1024 + 32 * nb; c.dst = (unsigned char*)(F.ws + WS_WD) + (size_t)e * 1024 * 1024 + (size_t)(32 * nb) * 1024 + 64 * kb; }
    return c;
}
#define CONV_LDW(it) ((it) < 32 * 16 * 64 ? 2048 : 1024)
__device__ __forceinline__ void conv_issue(const ConvItem& c, int ldw, float (&t)[32], int lane) {
    const float* s = c.src + (size_t)(lane >> 5) * ldw + (lane & 31);
#pragma unroll
    for (int i = 0; i < 32; ++i) t[i] = s[(size_t)(2 * i) * ldw];
}
__device__ __forceinline__ void conv_finish(const ConvItem& c, float (&t)[32], int lane) {
    unsigned w[8];
#pragma unroll
    for (int d = 0; d < 8; ++d) {
        auto r0 = __builtin_amdgcn_permlane32_swap(__float_as_uint(t[2 * d]), __float_as_uint(t[2 * d + 16]), false, false);
        auto r1 = __builtin_amdgcn_permlane32_swap(__float_as_uint(t[2 * d + 1]), __float_as_uint(t[2 * d + 17]), false, false);
        w[d] = pg8::pk4_fp8(__uint_as_float(r0[0]) * W_SCALE, __uint_as_float(r0[1]) * W_SCALE, __uint_as_float(r1[0]) * W_SCALE, __uint_as_float(r1[1]) * W_SCALE);
    }
    GAS v4u* o = (GAS v4u*)(c.dst + (size_t)(lane & 31) * 1024 + 32 * (lane >> 5));
    o[0] = (v4u){w[0], w[1], w[2], w[3]}; o[1] = (v4u){w[4], w[5], w[6], w[7]};
}

constexpr int RT_PITCH = 1032;
constexpr int RT_HI = 0, RT_LO = 16 * RT_PITCH * 2, RT_PART = 2 * 16 * RT_PITCH * 2, RT_HIST = RT_PART + 8 * 16 * 32 * 4;
constexpr int RW_WP = 1032, RW_WL = 32 * RW_WP * 2, RW_CA = 2 * RW_WL, RW_CB = RW_CA + 4096, RW_SC = RW_CB + 4096, RW_TE = RW_SC + NWAVES * 2048, RW_HIST = RW_TE + 128, RW_END = RW_HIST + 128;
static_assert(RW_END <= 161792 && 16 * 32 * 4 <= NWAVES * 2048, "router LDS");
__device__ __forceinline__ void p5_norm2_router_w(Frame& F, const int per) {
    typedef short bf16x8 __attribute__((ext_vector_type(8)));
    const float* g2n = F.in[22 + F.z]; const float* w_router = F.in[23 + F.z]; const float* b_router = F.in[24 + F.z];
    const float* mod = (const float*)(F.ws + WS_MOD); unsigned char* h2 = (unsigned char*)(F.ws + WS_H2);
    int* idxo = (int*)(F.ws + WS_IDX); float* gateo = (float*)(F.ws + WS_GATE);
    LAS unsigned char* L = F.lds; LAS int* hist = (LAS int*)(L + RW_HIST); LAS float* te = (LAS float*)(L + RW_TE);
    const int lane = F.lane, wave = F.wave, li = lane & 15, lg = lane >> 4;
    const int blk0 = F.vcu * per, b = (blk0 * 16) / SEQ;
    const bf16* x1b = (const bf16*)(F.ws + WS_X1);
    for (int q = F.tid; q < 256; q += NWAVES * 64) { const int col = 4 * q;
        const f32x4 g = *(const f32x4*)(g2n + col), sc = *(const f32x4*)(mod + (size_t)b * 6144 + 4096 + col);
        *(LAS f32x4*)(L + RW_CA + col * 4) = g * (sc + 1.0f); *(LAS f32x4*)(L + RW_CB + col * 4) = *(const f32x4*)(mod + (size_t)b * 6144 + 3072 + col); }
    if (F.tid < 32) hist[F.tid] = 0;
    __syncthreads();
    { const int e = F.tid & 31, part = F.tid >> 5; float tsum = 0.f;
      for (int kk = 0; kk < 64; ++kk) { const int k = 64 * part + kk; const float w = w_router[k * 32 + e];
          const float wp = w * ((const LAS float*)(L + RW_CA))[k]; tsum += w * ((const LAS float*)(L + RW_CB))[k];
          const unsigned hb = f2bf(wp);
          *(LAS unsigned short*)(L + (e * RW_WP + k) * 2) = (unsigned short)hb; *(LAS unsigned short*)(L + RW_WL + (e * RW_WP + k) * 2) = (unsigned short)f2bf(wp - __uint_as_float(hb << 16)); }
      ((LAS float*)(L + RW_SC))[part * 32 + e] = tsum; }
    __syncthreads();
    if (F.tid < 32) { float t = b_router[F.tid];
#pragma unroll
        for (int part = 0; part < 16; ++part) t += ((const LAS float*)(L + RW_SC))[part * 32 + F.tid];
        te[F.tid] = t; }
    __syncthreads();
    const float br = te[lane & 31];
    LAS float* sc_ = (LAS float*)(L + RW_SC + wave * 2048);
    const int e = lane & 31, hsh = lane & 32;
#define RW_LOAD(buf, c) do { _Pragma("unroll") for (int s_ = 0; s_ < 8; ++s_) buf[s_] = xr[4 * (8 * (c) + s_)]; } while (0)
#define RW_PASS_A(buf, c) do { _Pragma("unroll") for (int s_ = 0; s_ < 8; ++s_) { const int s = 8 * (c) + s_; \
            _Pragma("unroll") for (int j = 0; j < 4; ++j) { const float a0 = bflo(buf[s_][j]), a1 = bfhi(buf[s_][j]); ss += a0 * a0 + a1 * a1; } \
            const bf16x8 bx = __builtin_bit_cast(bf16x8, buf[s_]); \
            _Pragma("unroll") for (int jb = 0; jb < 2; ++jb) { const int wo = ((16 * jb + li) * RW_WP + 32 * s + 8 * lg) * 2; \
                acc[jb] = __builtin_amdgcn_mfma_f32_16x16x32_bf16(*(const LAS bf16x8*)(L + wo), bx, acc[jb], 0, 0, 0); \
                acc[jb] = __builtin_amdgcn_mfma_f32_16x16x32_bf16(*(const LAS bf16x8*)(L + RW_WL + wo), bx, acc[jb], 0, 0, 0); } \
            if (s_ & 1) __builtin_amdgcn_sched_barrier(0); } } while (0)
#define RW_PASS_B(buf, c) do { _Pragma("unroll") for (int s_ = 0; s_ < 8; ++s_) { const int s = 8 * (c) + s_; const v4u xw = buf[s_]; const int col = 32 * s + 8 * lg; \
            const f32x4 ca0 = *(const LAS f32x4*)(L + RW_CA + col * 4), ca1 = *(const LAS f32x4*)(L + RW_CA + col * 4 + 16), cb0 = *(const LAS f32x4*)(L + RW_CB + col * 4), cb1 = *(const LAS f32x4*)(L + RW_CB + col * 4 + 16); \
            float hv[8]; \
            _Pragma("unroll") for (int j = 0; j < 4; ++j) { hv[2 * j] = bflo(xw[j]) * rstd; hv[2 * j + 1] = bfhi(xw[j]) * rstd; } \
            _Pragma("unroll") for (int j = 0; j < 4; ++j) { hv[j] = (hv[j] * ca0[j] + cb0[j]) * H2_SCALE; hv[4 + j] = (hv[4 + j] * ca1[j] + cb1[j]) * H2_SCALE; } \
            *(GAS v2u*)(orow + 32 * s) = (v2u){pg8::pk4_fp8(hv[0], hv[1], hv[2], hv[3]), pg8::pk4_fp8(hv[4], hv[5], hv[6], hv[7])}; \
            if (s_ & 1) __builtin_amdgcn_sched_barrier(0); } } while (0)
    for (int it = wave; it < per; it += NWAVES) {
        const int m0 = (blk0 + it) * 16;
        const GAS v4u* xr = (const GAS v4u*)(x1b + (size_t)(m0 + li) * D + 8 * lg);
        v4u xa[8], xb[8];
        float ss = 0.f; f32x4 acc[2] = {{0.f, 0.f, 0.f, 0.f}, {0.f, 0.f, 0.f, 0.f}};
        RW_LOAD(xa, 0); RW_LOAD(xb, 1); RW_PASS_A(xa, 0); RW_LOAD(xa, 2); RW_PASS_A(xb, 1); RW_LOAD(xb, 3); RW_PASS_A(xa, 2); RW_LOAD(xa, 0); RW_PASS_A(xb, 3);
        { auto rr = __builtin_amdgcn_permlane16_swap(__float_as_uint(ss), __float_as_uint(ss), false, false); ss = __uint_as_float(rr[0]) + __uint_as_float(rr[1]); }
        { auto rr = __builtin_amdgcn_permlane32_swap(__float_as_uint(ss), __float_as_uint(ss), false, false); ss = __uint_as_float(rr[0]) + __uint_as_float(rr[1]); }
        const float rstd = 1.0f / sqrtf(ss * (1.0f / D) + 1e-6f);
#pragma unroll
        for (int jb = 0; jb < 2; ++jb) *(LAS f32x4*)(sc_ + li * 32 + 16 * jb + 4 * lg) = acc[jb] * rstd;
        unsigned char* orow = h2 + (size_t)(m0 + li) * D + 8 * lg;
        RW_LOAD(xb, 1); RW_PASS_B(xa, 0); RW_LOAD(xa, 2); RW_PASS_B(xb, 1); RW_LOAD(xb, 3); RW_PASS_B(xa, 2); RW_PASS_B(xb, 3);
        LDS_WAIT();
#pragma unroll 2
        for (int ps = 0; ps < 8; ++ps) {
            const int row = 2 * ps + (lane >> 5); float val = sc_[row * 32 + e] + br;
            float tv[4]; int tix[4];
#pragma unroll
            for (int k = 0; k < 4; ++k) { const float mx = half_max(val);
                const unsigned long long bal = __ballot(val == mx); const int who = __ffs((int)(unsigned)(bal >> hsh)) - 1;
                tv[k] = mx; tix[k] = who; if (e == who) val = -INFINITY; }
            const float e1 = __expf(tv[1] - tv[0]), e2 = __expf(tv[2] - tv[0]), e3 = __expf(tv[3] - tv[0]); const float inv = 1.0f / (1.0f + e1 + e2 + e3);
            if (e < 4) { const int ti = e == 0 ? tix[0] : e == 1 ? tix[1] : e == 2 ? tix[2] : tix[3]; const float tg = (e == 0 ? 1.0f : e == 1 ? e1 : e == 2 ? e2 : e3) * inv;
                const size_t mr = (size_t)m0 + row; idxo[mr * 4 + e] = ti; gateo[mr * 4 + e] = tg; __hip_atomic_fetch_add(&hist[ti], 1, __ATOMIC_RELAXED, __HIP_MEMORY_SCOPE_WORKGROUP); }
        }
        LDS_WAIT();
    }
#undef RW_LOAD
#undef RW_PASS_A
#undef RW_PASS_B
    __syncthreads();
    if (F.tid < 32) { const int hv_ = hist[F.tid]; if (hv_) __hip_atomic_fetch_add(F.ctl + CW_CNT + F.tid, (unsigned)hv_, __ATOMIC_RELAXED, __HIP_MEMORY_SCOPE_AGENT); }
}
__device__ __forceinline__ void p5_norm2_router(Frame& F, const int flags) {
    typedef short bf16x8 __attribute__((ext_vector_type(8)));
    const float* g2n = F.in[22 + F.z]; const float* b_router = F.in[24 + F.z];
    const float* mod = (const float*)(F.ws + WS_MOD); unsigned char* h2 = (unsigned char*)(F.ws + WS_H2);
    const bf16* wrh = (const bf16*)(F.ws + WS_WR); const bf16* wrl = wrh + 32 * 1024;
    int* idxo = (int*)(F.ws + WS_IDX); float* gateo = (float*)(F.ws + WS_GATE);
    LAS unsigned char* L = F.lds; LAS float* part = (LAS float*)(L + RT_PART); LAS int* hist = (LAS int*)(L + RT_HIST);
    const int lane = F.lane, wave = F.wave, li = lane & 15, lg = lane >> 4;
    if (F.tid < 32) hist[F.tid] = 0;
    const int gw = F.vcu * NWAVES + wave, NGW = F.G * NWAVES;
    bf16x8 wfh[2][4], wfl[2][4];
#pragma unroll
    for (int jb = 0; jb < 2; ++jb)
#pragma unroll
        for (int s = 0; s < 4; ++s) { const size_t o = (size_t)(16 * jb + li) * 1024 + 128 * wave + 32 * s + 8 * lg; wfh[jb][s] = *(const GAS bf16x8*)(wrh + o); wfl[jb][s] = *(const GAS bf16x8*)(wrl + o); }
    const float br = b_router[lane & 31];
    const int nblk = T / 16, per = (nblk + F.G - 1) / F.G;
    __syncthreads();
    const bf16* x1b = (const bf16*)(F.ws + WS_X1);
    v2u nxa[4], nxb[4]; f32x4 cAv[4], cBv[4]; int cb_ = -1;
    if (F.vcu * per < nblk) { const GAS v2u* xr = (const GAS v2u*)(x1b + (size_t)(F.vcu * per * 16 + 2 * wave) * D) + lane;
#pragma unroll
        for (int j = 0; j < 4; ++j) { nxa[j] = xr[64 * j]; nxb[j] = xr[256 + 64 * j]; } }
    if (!(flags & 4)) for (int it = 0; it < per; ++it) {
        const int blk = F.vcu * per + it;
        if (blk < nblk) {
            const int m = blk * 16 + 2 * wave, b = m / SEQ;
            f32x4 va[4], vb[4]; float ssa = 0.f, ssb = 0.f;
#pragma unroll
            for (int j = 0; j < 4; ++j) { va[j] = (f32x4){bflo(nxa[j].x), bfhi(nxa[j].x), bflo(nxa[j].y), bfhi(nxa[j].y)}; vb[j] = (f32x4){bflo(nxb[j].x), bfhi(nxb[j].x), bflo(nxb[j].y), bfhi(nxb[j].y)}; }
            if (it + 1 < per && blk + 1 < nblk) { const GAS v2u* xr = (const GAS v2u*)(x1b + (size_t)(m + 16) * D) + lane;
#pragma unroll
                for (int j = 0; j < 4; ++j) { nxa[j] = xr[64 * j]; nxb[j] = xr[256 + 64 * j]; } }
#pragma unroll
            for (int j = 0; j < 4; ++j) { ssa += (va[j].x * va[j].x + va[j].y * va[j].y) + (va[j].z * va[j].z + va[j].w * va[j].w); ssb += (vb[j].x * vb[j].x + vb[j].y * vb[j].y) + (vb[j].z * vb[j].z + vb[j].w * vb[j].w); }
            const float rsa = 1.0f / sqrtf(wave_sum(ssa) * (1.0f / D) + 1e-6f), rsb = 1.0f / sqrtf(wave_sum(ssb) * (1.0f / D) + 1e-6f);
            GAS unsigned* o4 = (GAS unsigned*)(h2 + (size_t)m * D) + lane;
            if (b != cb_) { cb_ = b;
#pragma unroll
                for (int j = 0; j < 4; ++j) { const int col = 4 * lane + 256 * j;
                    const f32x4 g = *(const f32x4*)(g2n + col), sc = *(const f32x4*)(mod + (size_t)b * 6144 + 4096 + col); cAv[j] = g * (sc + 1.0f); cBv[j] = *(const f32x4*)(mod + (size_t)b * 6144 + 3072 + col); } }
#pragma unroll
            for (int j = 0; j < 4; ++j) { const int col = 4 * lane + 256 * j;
                va[j] = va[j] * rsa * cAv[j] + cBv[j]; vb[j] = vb[j] * rsb * cAv[j] + cBv[j];
                o4[64 * j] = pg8::pk4_fp8(va[j].x * H2_SCALE, va[j].y * H2_SCALE, va[j].z * H2_SCALE, va[j].w * H2_SCALE);
                o4[256 + 64 * j] = pg8::pk4_fp8(vb[j].x * H2_SCALE, vb[j].y * H2_SCALE, vb[j].z * H2_SCALE, vb[j].w * H2_SCALE);
#define RT_SPLIT(v_, row_) do { const unsigned p0_ = attn_body::cvtpk_s((v_).x, (v_).y), p1_ = attn_body::cvtpk_s((v_).z, (v_).w);     \
                    *(LAS v2u*)(L + RT_HI + ((row_) * RT_PITCH + col) * 2) = (v2u){p0_, p1_}; \
                    *(LAS v2u*)(L + RT_LO + ((row_) * RT_PITCH + col) * 2) = (v2u){attn_body::cvtpk_s((v_).x - bflo(p0_), (v_).y - bfhi(p0_)), attn_body::cvtpk_s((v_).z - bflo(p1_), (v_).w - bfhi(p1_))}; } while (0)
                RT_SPLIT(va[j], 2 * wave); RT_SPLIT(vb[j], 2 * wave + 1);
#undef RT_SPLIT
            }
        }
        LDS_BARRIER();
        {
            f32x4 acc[2] = {{0.f, 0.f, 0.f, 0.f}, {0.f, 0.f, 0.f, 0.f}};
#pragma unroll
            for (int s = 0; s < 4; ++s) {
                const int eo = (li * RT_PITCH + 128 * wave + 32 * s + 8 * lg) * 2;
                const bf16x8 bh = *(const LAS bf16x8*)(L + RT_HI + eo), bl = *(const LAS bf16x8*)(L + RT_LO + eo);
#pragma unroll
                for (int jb = 0; jb < 2; ++jb) {
                    acc[jb] = __builtin_amdgcn_mfma_f32_16x16x32_bf16(wfh[jb][s], bh, acc[jb], 0, 0, 0);
                    acc[jb] = __builtin_amdgcn_mfma_f32_16x16x32_bf16(wfh[jb][s], bl, acc[jb], 0, 0, 0);
                    acc[jb] = __builtin_amdgcn_mfma_f32_16x16x32_bf16(wfl[jb][s], bh, acc[jb], 0, 0, 0);
                }
            }
#pragma unroll
            for (int jb = 0; jb < 2; ++jb) *(LAS f32x4*)(part + (wave * 16 + li) * 32 + 16 * jb + 4 * lg) = acc[jb];
        }
        LDS_BARRIER();
        if (blk < nblk) {
            const int row = 2 * wave + (lane >> 5), e = lane & 31; float val = br;
#pragma unroll
            for (int w = 0; w < 8; ++w) val += part[(w * 16 + row) * 32 + e];
            float tv[4]; int tix[4]; const int hsh = lane & 32;
#pragma unroll
            for (int k = 0; k < 4; ++k) { const float mx = half_max(val);
                const unsigned long long bal = __ballot(val == mx); const int who = __ffs((int)(unsigned)(bal >> hsh)) - 1;
                tv[k] = mx; tix[k] = who; if (e == who) val = -INFINITY; }
            const float e1 = __expf(tv[1] - tv[0]), e2 = __expf(tv[2] - tv[0]), e3 = __expf(tv[3] - tv[0]); const float inv = 1.0f / (1.0f + e1 + e2 + e3);
            if (e < 4) { const int ti = e == 0 ? tix[0] : e == 1 ? tix[1] : e == 2 ? tix[2] : tix[3]; const float tg = (e == 0 ? 1.0f : e == 1 ? e1 : e == 2 ? e2 : e3) * inv;
                const size_t mr = (size_t)blk * 16 + row; idxo[mr * 4 + e] = ti; gateo[mr * 4 + e] = tg; __hip_atomic_fetch_add(&hist[ti], 1, __ATOMIC_RELAXED, __HIP_MEMORY_SCOPE_WORKGROUP); }
        }
        LDS_BARRIER();
    }
    __syncthreads();
    if (F.tid < 32) { const int hv = hist[F.tid]; if (hv) __hip_atomic_fetch_add(F.ctl + CW_CNT + F.tid, (unsigned)hv, __ATOMIC_RELAXED, __HIP_MEMORY_SCOPE_AGENT); }
}

__device__ __forceinline__ void p6_positions(Frame& F) {
    const int* idxo = (const int*)(F.ws + WS_IDX); int* pos_of = (int*)(F.ws + WS_POS); int* stok = (int*)(F.ws + WS_STOK);
    LAS int* lcount = (LAS int*)F.lds; LAS int* gbase = lcount + 32; LAS int* pstart = lcount + 64;
    for (int tg = F.vcu; tg < T / 256; tg += F.G) {
        if (F.tid < 32) lcount[F.tid] = 0;
        if (F.wave == 0) { int cnt = F.lane < 32 ? (int)F.ctl[CW_CNT + F.lane] : 0; const int padded = (cnt + 255) & ~255; int incl = padded;
#pragma unroll
            for (int o = 1; o < 32; o <<= 1) { const int t = __shfl_up(incl, o); if (F.lane >= o) incl += t; }
            if (F.lane < 32) pstart[F.lane] = incl - padded; }
        __syncthreads();
        int e[2], lr[2];
#pragma unroll
        for (int j = 0; j < 2; ++j) { const int s = F.tid * 2 + j; e[j] = idxo[(size_t)tg * 1024 + s]; lr[j] = __hip_atomic_fetch_add(&lcount[e[j]], 1, __ATOMIC_RELAXED, __HIP_MEMORY_SCOPE_WORKGROUP); }
        __syncthreads();
        if (F.tid < 32) gbase[F.tid] = (int)__hip_atomic_fetch_add(F.ctl + CW_CUR + F.tid, (unsigned)lcount[F.tid], __ATOMIC_RELAXED, __HIP_MEMORY_SCOPE_AGENT);
        __syncthreads();
#pragma unroll
        for (int j = 0; j < 2; ++j) { const int s = F.tid * 2 + j; const int pos = pstart[e[j]] + gbase[e[j]] + lr[j]; stok[pos] = tg * 256 + (s >> 2); pos_of[(size_t)tg * 1024 + s] = pos; }
        __syncthreads();
    }
}

__device__ __forceinline__ int moe_tables(Frame& F) {
    LAS unsigned char* blk2e = (LAS unsigned char*)(F.lds + BLK2E_OFF); LAS unsigned short* blkvalid = (LAS unsigned short*)(F.lds + BLKVALID_OFF);
    __syncthreads();
    if (F.wave == 0) { const int cnt = F.lane < 32 ? (int)F.ctl[CW_CNT + F.lane] : 0; const int nb = (cnt + 255) >> 8; int incl = nb;
#pragma unroll
        for (int o = 1; o < 32; o <<= 1) { const int t = __shfl_up(incl, o); if (F.lane >= o) incl += t; }
        const int st = incl - nb;
        for (int j = 0; j < nb; ++j) { blk2e[st + j] = (unsigned char)F.lane; const int rem = cnt - 256 * j; blkvalid[st + j] = (unsigned short)(rem < 256 ? rem : 256); }
        if (F.lane == 31) F.MISC[16] = (unsigned)incl; }
    __syncthreads();
    return (int)F.MISC[16];
}

__device__ __forceinline__ void p9_combine(Frame& F) {
    const float* mod = (const float*)(F.ws + WS_MOD); const float* fg = F.in[29 + F.z];
    const int* pos_of = (const int*)(F.ws + WS_POS); const float* gateo = (const float*)(F.ws + WS_GATE); const unsigned char* ys = (const unsigned char*)(F.ws + WS_YS);
    const int gw = F.vcu * NWAVES + F.wave, NGW = F.G * NWAVES, lane = F.lane;
    typedef int i32x4v __attribute__((ext_vector_type(4)));
    const bf16* x1b = (const bf16*)(F.ws + WS_X1);
    struct RowBuf { v2u x[4]; unsigned y[4][4]; };
#define P9_ISSUE(buf, mrow, ps) do { const GAS v2u* xr_ = (const GAS v2u*)(x1b + (size_t)(mrow) * D) + lane; \
        _Pragma("unroll") for (int j = 0; j < 4; ++j) (buf).x[j] = xr_[64 * j]; \
        _Pragma("unroll") for (int k = 0; k < 4; ++k) { const GAS unsigned* yr_ = (const GAS unsigned*)(ys + (size_t)(ps)[k] * D) + lane; \
            _Pragma("unroll") for (int j = 0; j < 4; ++j) (buf).y[k][j] = yr_[64 * j]; } } while (0)
    for (int rg = gw; rg < T / 32; rg += NGW) {
        const int m0 = rg * 32, b = m0 / SEQ;
        f32x4 g2v[4], fgv[4];
#pragma unroll
        for (int j = 0; j < 4; ++j) { const int col = 4 * lane + 256 * j; g2v[j] = *(const f32x4*)(mod + (size_t)b * 6144 + 5120 + col); fgv[j] = *(const f32x4*)(fg + col); }
        i32x4v ps1 = *(const GAS i32x4v*)(pos_of + (size_t)m0 * 4), ps2 = *(const GAS i32x4v*)(pos_of + (size_t)(m0 + 1) * 4);
        f32x4 gt0, gt1 = *(const GAS f32x4*)(gateo + (size_t)m0 * 4), gt2 = *(const GAS f32x4*)(gateo + (size_t)(m0 + 1) * 4);
        RowBuf nb; P9_ISSUE(nb, m0, ps1);
        for (int r = 0; r < 32; ++r) {
            const int m = m0 + r;
            const RowBuf cb = nb; gt0 = gt1;
            if (r + 1 < 32) { P9_ISSUE(nb, m + 1, ps2); gt1 = gt2; }
            if (r + 2 < 32) { ps2 = *(const GAS i32x4v*)(pos_of + (size_t)(m + 2) * 4); gt2 = *(const GAS f32x4*)(gateo + (size_t)(m + 2) * 4); }
            f32x4 acc[4];
#pragma unroll
            for (int j = 0; j < 4; ++j) acc[j] = (f32x4){0.f, 0.f, 0.f, 0.f};
#pragma unroll
            for (int k = 0; k < 4; ++k)
#pragma unroll
                for (int j = 0; j < 4; ++j) { const unsigned w = cb.y[k][j]; const f32x2 lo2 = __builtin_amdgcn_cvt_pk_f32_fp8((int)w, false), hi2 = __builtin_amdgcn_cvt_pk_f32_fp8((int)w, true); acc[j] += (f32x4){lo2.x, lo2.y, hi2.x, hi2.y} * (gt0[k] * (1.0f / YS_SCALE)); }
            f32x4 z[4]; float ss = 0.f;
#pragma unroll
            for (int j = 0; j < 4; ++j) { z[j] = (f32x4){bflo(cb.x[j].x), bfhi(cb.x[j].x), bflo(cb.x[j].y), bfhi(cb.x[j].y)} + g2v[j] * acc[j]; ss += (z[j].x * z[j].x + z[j].y * z[j].y) + (z[j].z * z[j].z + z[j].w * z[j].w); }
            const float rstd = 1.0f / sqrtf(wave_sum(ss) * (1.0f / D) + 1e-6f);
#ifdef RWC_CMP
            { const float e2 = ((const float*)F.ctl)[600], r2 = ((const float*)F.ctl)[601]; const float sc = 1.0f + sqrtf(e2 / fmaxf(r2, 1e-30f));
#pragma unroll
              for (int j = 0; j < 4; ++j) z[j] = z[j] * sc; }
#endif
            GAS f32x4* xo = (GAS f32x4*)(F.out + (size_t)m * D) + lane;
#pragma unroll
            for (int j = 0; j < 4; ++j) xo[64 * j] = z[j] * rstd * fgv[j];
        }
    }
#undef P9_ISSUE
}
namespace rwc {
typedef short bf16x8 __attribute__((ext_vector_type(8)));
typedef short s16x4 __attribute__((ext_vector_type(4)));
constexpr int PITCH = 72, MATB = 64 * PITCH * 2;
enum { B_PA = 0, B_AB, B_VT, B_BT, B_KT, B_M1, B_LD, B_RB, B_P1, B_P2, B_XA, B_WO, B_S0, B_S1, B_GT, NBUF };
constexpr int B_EH = B_AB, B_EL = B_M1;
constexpr int OFF_CUM = NBUF * MATB, OFF_GEND = OFF_CUM + 64 * 64 * 4, OFF_BONUS = OFF_GEND + 256, OFF_CST = OFF_BONUS + 512, RWC_BYTES = OFF_CST + 10 * 64 * 4;
static_assert(RWC_BYTES <= 161792, "chunked RWKV LDS");
typedef const LAS unsigned char* lcp;
__device__ __forceinline__ bf16x8 frag_rm(lcp img, int rb, int s, int lane) { return *(const LAS bf16x8*)(img + ((16 * rb + (lane & 15)) * PITCH + 32 * s + 8 * (lane >> 4)) * 2); }
__device__ __forceinline__ bf16x8 frag_tr(lcp img, int cb, int s, int lane) {
#ifdef RWC_SLOW_TR
    bf16x8 o_;
#pragma unroll
    for (int jj = 0; jj < 8; ++jj) o_[jj] = *(const LAS short*)(img + ((32 * s + 8 * (lane >> 4) + jj) * PITCH + 16 * cb + (lane & 15)) * 2);
    return o_;
#endif
    const int q = (lane & 15) >> 2, p = lane & 3; lcp a = img + ((32 * s + 8 * (lane >> 4) + q) * PITCH + 16 * cb + 4 * p) * 2;
    const s16x4 lo = __builtin_bit_cast(s16x4, __builtin_amdgcn_ds_read_tr16_b64_v4i16((LAS attn_body::v4i16_t*)a));
    const s16x4 hi = __builtin_bit_cast(s16x4, __builtin_amdgcn_ds_read_tr16_b64_v4i16((LAS attn_body::v4i16_t*)(a + 4 * PITCH * 2)));
    return (bf16x8){lo[0], lo[1], lo[2], lo[3], hi[0], hi[1], hi[2], hi[3]};
}
#define RWC_MMA(acc, afrag, bfrag) acc = __builtin_amdgcn_mfma_f32_16x16x32_bf16(afrag, bfrag, acc, 0, 0, 0)
__device__ __forceinline__ void store_tile(LAS unsigned char* img, int ib, int jb, int lane, const f32x4& a) {
    *(LAS v2u*)(img + ((16 * ib + (lane & 15)) * PITCH + 16 * jb + 4 * (lane >> 4)) * 2) = (v2u){attn_body::cvtpk_s(a[0], a[1]), attn_body::cvtpk_s(a[2], a[3])};
}
}

struct RwcRaw { v4u rw, kw, vw, rwp, kwp, vwp, lw, la; };
__device__ __forceinline__ void rwc_fetch(RwcRaw& x, const bf16* p, const bf16* lo, size_t m, int t, int h, int c0) {
    const bf16* pr = p + m * NP + h * 64 + c0;
    x.rw = *(const GAS v4u*)(pr); x.kw = *(const GAS v4u*)(pr + 512); x.vw = *(const GAS v4u*)(pr + 1024);
    x.rwp = (v4u){0u, 0u, 0u, 0u}; x.kwp = x.rwp; x.vwp = x.rwp;
    if (t > 0) { x.rwp = *(const GAS v4u*)(pr - NP); x.kwp = *(const GAS v4u*)(pr - NP + 512); x.vwp = *(const GAS v4u*)(pr - NP + 1024); }
    x.lw = *(const GAS v4u*)(lo + m * NLORA + h * 64 + c0); x.la = *(const GAS v4u*)(lo + m * NLORA + 512 + h * 64 + c0);
}
__device__ __forceinline__ void rwkv_unit_chunked(Frame& F, int bh, bf16* yout, int ypitch, const int dflags = 0) {
    using namespace rwc;
    const int b = bh >> 3, h = bh & 7, tid = F.tid, lane = F.lane, wave = F.wave;
    const bf16* p = (const bf16*)(F.ws + WS_P); const bf16* lo = (const bf16*)(F.ws + WS_LORA);
    LAS unsigned char* L = F.lds;
#define IMG(i) (L + (i) * MATB)
    LAS float* cum = (LAS float*)(L + OFF_CUM); LAS float* gend = (LAS float*)(L + OFF_GEND); LAS float* bonus = (LAS float*)(L + OFF_BONUS); LAS float* cst = (LAS float*)(L + OFF_CST);
    __syncthreads();
    if (tid < 64) { const int c = h * 64 + tid; const float* mu = F.in[6 + F.z];
        cst[0 * 64 + tid] = mu[c]; cst[1 * 64 + tid] = mu[512 + c]; cst[2 * 64 + tid] = mu[1024 + c];
        cst[3 * 64 + tid] = F.in[7 + F.z][c]; cst[4 * 64 + tid] = F.in[9 + F.z][c]; cst[5 * 64 + tid] = F.in[12 + F.z][c]; cst[6 * 64 + tid] = F.in[13 + F.z][c];
        cst[7 * 64 + tid] = F.in[14 + F.z][c]; cst[8 * 64 + tid] = F.in[15 + F.z][c]; cst[9 * 64 + tid] = F.in[16 + F.z][c]; }
    const int tib[2] = {(2 * wave) >> 2, (2 * wave + 1) >> 2}, tjb[2] = {(2 * wave) & 3, (2 * wave + 1) & 3};
    const int li = lane & 15, lg = lane >> 4;
    bf16x8 ltf[2];
#pragma unroll
    for (int s = 0; s < 2; ++s)
#pragma unroll
        for (int j = 0; j < 8; ++j) ltf[s][j] = (32 * s + 8 * lg + j <= 16 * (wave & 3) + li) ? (short)0x3f80 : (short)0;
    f32x4 accS[2];
#pragma unroll
    for (int u = 0; u < 2; ++u) accS[u] = (f32x4){0.f, 0.f, 0.f, 0.f};
    for (int e = tid; e < MATB / 4; e += NWAVES * 64) { ((LAS unsigned*)IMG(B_S0))[e] = 0u; ((LAS unsigned*)IMG(B_LD))[e] = 0u; ((LAS unsigned*)IMG(B_WO))[e] = 0u; }
    const size_t mb = (size_t)b * SEQ;
    const int et = tid >> 3, ec0 = (tid & 7) * 8;
    constexpr int NCH = SEQ / 64;
    RwcRaw nx;
    rwc_fetch(nx, p, lo, mb + et, et, h, ec0);
    __syncthreads();
    float o_al[8], o_be[8], o_kf[8], o_r[8], o_v[8], o_ew[8];
    v4u gw = {0u, 0u, 0u, 0u};
    { const int cp = 0; const RwcRaw x = nx;
      rwc_fetch(nx, p, lo, mb + 64 + et, 64 + et, h, ec0);
      gw = *(const GAS v4u*)(lo + (mb + et) * NLORA + 1024 + h * 64 + ec0);
#pragma unroll
        for (int j = 0; j < 8; ++j) { o_al[j] = 0.f; o_be[j] = 0.f; o_kf[j] = 0.f; o_r[j] = 0.f; o_v[j] = 0.f; o_ew[j] = 0.f; }
        {
            float kn[8], aa[8]; float ss = 0.f, bq = 0.f;
#pragma unroll
            for (int j = 0; j < 8; ++j) {
                const int c = ec0 + j;
#define BFJ(w) __uint_as_float(((j & 1) ? (w[j >> 1] & 0xffff0000u) : (w[j >> 1] << 16)))
                const float rc = BFJ(x.rw), kc = BFJ(x.kw), vc = BFJ(x.vw), rp = BFJ(x.rwp), kp = BFJ(x.kwp), vp = BFJ(x.vwp), lwv = BFJ(x.lw), lav = BFJ(x.la);
#undef BFJ
                o_r[j] = rc + cst[0 * 64 + c] * (rp - rc); const float kk = kc + cst[1 * 64 + c] * (kp - kc); o_v[j] = vc + cst[2 * 64 + c] * (vp - vc);
                o_ew[j] = 0.6065306597f * __builtin_amdgcn_rcpf(1.0f + __expf(-(cst[3 * 64 + c] + lwv)));
                aa[j] = __builtin_amdgcn_rcpf(1.0f + __expf(-(cst[4 * 64 + c] + lav)));
                kn[j] = kk * cst[5 * 64 + c]; ss += kn[j] * kn[j];
                o_kf[j] = kk * (1.0f + (aa[j] - 1.0f) * cst[6 * 64 + c]);
                bq += o_r[j] * o_kf[j] * cst[7 * 64 + c];
            }
            ss = sum8(ss); bq = sum8(bq);
            const float inv = __builtin_amdgcn_rsqf(fmaxf(ss, 1e-24f));
            if ((tid & 7) == 0) bonus[(cp & 1) * 64 + et] = bq;
            unsigned eh[4], el[4];
#pragma unroll
            for (int j = 0; j < 8; ++j) { const float kkn = kn[j] * inv; o_al[j] = -kkn; o_be[j] = kkn * aa[j]; }
#pragma unroll
            for (int j = 0; j < 4; ++j) { const unsigned hi0 = f2bf(o_ew[2 * j]), hi1 = f2bf(o_ew[2 * j + 1]);
                eh[j] = hi0 | (hi1 << 16); el[j] = pk2(o_ew[2 * j] - __uint_as_float(hi0 << 16), o_ew[2 * j + 1] - __uint_as_float(hi1 << 16)); }
            *(LAS v4u*)(IMG(B_EH) + (et * PITCH + ec0) * 2) = (v4u){eh[0], eh[1], eh[2], eh[3]};
            *(LAS v4u*)(IMG(B_EL) + (et * PITCH + ec0) * 2) = (v4u){el[0], el[1], el[2], el[3]};
        }
    }
        LDS_BARRIER();
        if (wave >= 4) {
            const int ib = wave - 4;
#pragma unroll
            for (int jb = 0; jb < 4; ++jb) {
                f32x4 aC = {0.f, 0.f, 0.f, 0.f};
#pragma unroll
                for (int s = 0; s < 2; ++s) { RWC_MMA(aC, frag_tr(IMG(B_EH), jb, s, lane), ltf[s]); RWC_MMA(aC, frag_tr(IMG(B_EL), jb, s, lane), ltf[s]); }
                *(LAS f32x4*)(cum + (16 * ib + li) * 64 + 16 * jb + 4 * lg) = aC;
            }
        }
        LDS_BARRIER();
         {
            const f32x4 c0v = *(const LAS f32x4*)(cum + et * 64 + ec0), c1v = *(const LAS f32x4*)(cum + et * 64 + ec0 + 4);
            unsigned wab[4], wbt[4], wkt[4], wrb[4], wvt[4]; float gi8[8];
#pragma unroll
            for (int j = 0; j < 8; j += 2) {
                float va[2], vb[2], vk[2], vr[2];
#pragma unroll
                for (int q = 0; q < 2; ++q) { const float ci = (j + q) < 4 ? c0v[(j + q) & 3] : c1v[(j + q) & 3];
                    const float gi = __expf(-ci), ginv = __expf(ci), ge = __expf(o_ew[j + q] - ci);
                    gi8[j + q] = gi; va[q] = o_al[j + q] * ge; vb[q] = o_be[j + q] * ginv; vk[q] = o_kf[j + q] * ginv; vr[q] = o_r[j + q] * gi; }
                wab[j >> 1] = attn_body::cvtpk_s(va[0], va[1]); wbt[j >> 1] = attn_body::cvtpk_s(vb[0], vb[1]); wkt[j >> 1] = attn_body::cvtpk_s(vk[0], vk[1]);
                wrb[j >> 1] = attn_body::cvtpk_s(vr[0], vr[1]); wvt[j >> 1] = attn_body::cvtpk_s(o_v[j], o_v[j + 1]);
            }
            const int eo = (et * PITCH + ec0) * 2;
            *(LAS v4u*)(IMG(B_AB) + eo) = (v4u){wab[0], wab[1], wab[2], wab[3]}; *(LAS v4u*)(IMG(B_BT) + eo) = (v4u){wbt[0], wbt[1], wbt[2], wbt[3]};
            *(LAS v4u*)(IMG(B_KT) + eo) = (v4u){wkt[0], wkt[1], wkt[2], wkt[3]}; *(LAS v4u*)(IMG(B_RB) + eo) = (v4u){wrb[0], wrb[1], wrb[2], wrb[3]};
            *(LAS v4u*)(IMG(B_VT) + eo) = (v4u){wvt[0], wvt[1], wvt[2], wvt[3]};
            if (et == 63) { *(LAS f32x4*)(gend + ec0) = (f32x4){gi8[0], gi8[1], gi8[2], gi8[3]}; *(LAS f32x4*)(gend + ec0 + 4) = (f32x4){gi8[4], gi8[5], gi8[6], gi8[7]}; }
        }
        LDS_BARRIER();
    for (int ch = 0; ch < NCH; ++ch) {
        LAS unsigned char* s_cur = IMG(B_S0 + (ch & 1)); LAS unsigned char* s_nxt = IMG(B_S0 + ((ch + 1) & 1));
        const bool more = ch + 1 < NCH; v4u gwn = gw;
        {
            const int ib = tib[0];
            f32x4 aN[2], aM[2], aP1[2], aP2[2];
#pragma unroll
            for (int u = 0; u < 2; ++u) { aN[u] = (f32x4){0.f, 0.f, 0.f, 0.f}; aM[u] = aN[u]; aP1[u] = aN[u]; aP2[u] = aN[u]; }
#pragma unroll
            for (int s = 0; s < 2; ++s) {
                const bf16x8 fab = frag_rm(IMG(B_AB), ib, s, lane), frb = frag_rm(IMG(B_RB), ib, s, lane);
#pragma unroll
                for (int u = 0; u < 2; ++u) { const bf16x8 fbt = frag_rm(IMG(B_BT), tjb[u], s, lane), fkt = frag_rm(IMG(B_KT), tjb[u], s, lane);
                    RWC_MMA(aN[u], fbt, fab); RWC_MMA(aM[u], fkt, fab); RWC_MMA(aP1[u], fbt, frb); RWC_MMA(aP2[u], fkt, frb); }
            }
            const int ti_ = 16 * ib + li;
#pragma unroll
            for (int u = 0; u < 2; ++u) { const int jb = tjb[u];
#pragma unroll
                for (int r = 0; r < 4; ++r) { const int j = 16 * jb + 4 * lg + r;
                    if (!(j < ti_)) { aN[u][r] = 0.f; aM[u][r] = 0.f; } if (!(j <= ti_)) { aP1[u][r] = 0.f; aP2[u][r] = 0.f; } }
                store_tile(IMG(B_PA), ib, jb, lane, aN[u]); store_tile(IMG(B_M1), ib, jb, lane, aM[u]);
                store_tile(IMG(B_P1), ib, jb, lane, aP1[u]); store_tile(IMG(B_P2), ib, jb, lane, aP2[u]); }
        }
        LDS_BARRIER();
        if (wave < 4) {
            const int bb = wave, jc = lane & 15, mp = lane >> 4; float Lm[4] = {0.f, 0.f, 0.f, 0.f};
            lcp nb = IMG(B_PA) + ((16 * bb) * PITCH + 16 * bb + mp) * 2;
#pragma unroll
            for (int t = 0; t < 16; ++t) {
                float part = 0.f;
#pragma unroll
                for (int q = 0; q < 4; ++q) if (4 * q < t) part += bflo(*(const LAS unsigned short*)(nb + t * PITCH * 2 + 8 * q)) * Lm[q];
                { auto rr = __builtin_amdgcn_permlane16_swap(__float_as_uint(part), __float_as_uint(part), false, false); part = __uint_as_float(rr[0]) + __uint_as_float(rr[1]); }
                { auto rr = __builtin_amdgcn_permlane32_swap(__float_as_uint(part), __float_as_uint(part), false, false); part = __uint_as_float(rr[0]) + __uint_as_float(rr[1]); }
                const float lt = part + ((t == jc) ? 1.0f : 0.0f);
                if ((t & 3) == mp) Lm[t >> 2] = lt;
            }
#pragma unroll
            for (int q = 0; q < 4; ++q) *(LAS unsigned short*)(IMG(B_LD) + ((16 * bb + 4 * q + mp) * PITCH + 16 * bb + jc) * 2) = (unsigned short)f2bf(Lm[q]);
        }
        else {
            const int ib = wave - 4;
            f32x4 aG[4] = {{0.f, 0.f, 0.f, 0.f}, {0.f, 0.f, 0.f, 0.f}, {0.f, 0.f, 0.f, 0.f}, {0.f, 0.f, 0.f, 0.f}};
#pragma unroll
            for (int s = 0; s < 2; ++s) { const bf16x8 fs = frag_rm(s_cur, ib, s, lane), fv = frag_tr(IMG(B_VT), ib, s, lane);
#pragma unroll
                for (int jb = 0; jb < 4; ++jb) { RWC_MMA(aG[jb], frag_rm(IMG(B_AB), jb, s, lane), fs); RWC_MMA(aG[jb], frag_rm(IMG(B_M1), jb, s, lane), fv); } }
#pragma unroll
            for (int jb = 0; jb < 4; ++jb) store_tile(IMG(B_GT), ib, jb, lane, aG[jb]);
        }
        LDS_BARRIER();
        if (wave < 6) {
            const int b = wave == 0 ? 1 : (wave < 3 ? 2 : 3), bp = wave == 0 ? 0 : (wave < 3 ? wave - 1 : wave - 3), s = b >> 1;
            f32x4 aW = {0.f, 0.f, 0.f, 0.f};
            RWC_MMA(aW, frag_tr(IMG(B_PA), bp, s, lane), frag_rm(IMG(B_LD), b, s, lane));
            store_tile(IMG(B_WO), b, bp, lane, aW);
        }
        if (more) { const int cp = ch + 1; const RwcRaw x = nx;
            if (ch + 2 < NCH) rwc_fetch(nx, p, lo, mb + (size_t)(ch + 2) * 64 + et, (ch + 2) * 64 + et, h, ec0);
            gwn = *(const GAS v4u*)(lo + (mb + (size_t)(ch + 1) * 64 + et) * NLORA + 1024 + h * 64 + ec0);
#pragma unroll
        for (int j = 0; j < 8; ++j) { o_al[j] = 0.f; o_be[j] = 0.f; o_kf[j] = 0.f; o_r[j] = 0.f; o_v[j] = 0.f; o_ew[j] = 0.f; }
        {
            float kn[8], aa[8]; float ss = 0.f, bq = 0.f;
#pragma unroll
            for (int j = 0; j < 8; ++j) {
                const int c = ec0 + j;
#define BFJ(w) __uint_as_float(((j & 1) ? (w[j >> 1] & 0xffff0000u) : (w[j >> 1] << 16)))
                const float rc = BFJ(x.rw), kc = BFJ(x.kw), vc = BFJ(x.vw), rp = BFJ(x.rwp), kp = BFJ(x.kwp), vp = BFJ(x.vwp), lwv = BFJ(x.lw), lav = BFJ(x.la);
#undef BFJ
                o_r[j] = rc + cst[0 * 64 + c] * (rp - rc); const float kk = kc + cst[1 * 64 + c] * (kp - kc); o_v[j] = vc + cst[2 * 64 + c] * (vp - vc);
                o_ew[j] = 0.6065306597f * __builtin_amdgcn_rcpf(1.0f + __expf(-(cst[3 * 64 + c] + lwv)));
                aa[j] = __builtin_amdgcn_rcpf(1.0f + __expf(-(cst[4 * 64 + c] + lav)));
                kn[j] = kk * cst[5 * 64 + c]; ss += kn[j] * kn[j];
                o_kf[j] = kk * (1.0f + (aa[j] - 1.0f) * cst[6 * 64 + c]);
                bq += o_r[j] * o_kf[j] * cst[7 * 64 + c];
            }
            ss = sum8(ss); bq = sum8(bq);
            const float inv = __builtin_amdgcn_rsqf(fmaxf(ss, 1e-24f));
            if ((tid & 7) == 0) bonus[(cp & 1) * 64 + et] = bq;
            unsigned eh[4], el[4];
#pragma unroll
            for (int j = 0; j < 8; ++j) { const float kkn = kn[j] * inv; o_al[j] = -kkn; o_be[j] = kkn * aa[j]; }
#pragma unroll
            for (int j = 0; j < 4; ++j) { const unsigned hi0 = f2bf(o_ew[2 * j]), hi1 = f2bf(o_ew[2 * j + 1]);
                eh[j] = hi0 | (hi1 << 16); el[j] = pk2(o_ew[2 * j] - __uint_as_float(hi0 << 16), o_ew[2 * j + 1] - __uint_as_float(hi1 << 16)); }
            *(LAS v4u*)(IMG(B_EH) + (et * PITCH + ec0) * 2) = (v4u){eh[0], eh[1], eh[2], eh[3]};
            *(LAS v4u*)(IMG(B_EL) + (et * PITCH + ec0) * 2) = (v4u){el[0], el[1], el[2], el[3]};
        }
        }
        LDS_BARRIER();
        if (wave < 4) {
            const bf16x8 l0 = frag_rm(IMG(B_LD), 0, 0, lane), l1 = frag_rm(IMG(B_LD), 1, 0, lane), l2 = frag_rm(IMG(B_LD), 2, 1, lane), l3 = frag_rm(IMG(B_LD), 3, 1, lane);
            const bf16x8 w10 = frag_rm(IMG(B_WO), 1, 0, lane), w20 = frag_rm(IMG(B_WO), 2, 0, lane), w30 = frag_rm(IMG(B_WO), 3, 0, lane), w31 = frag_rm(IMG(B_WO), 3, 1, lane);
            bf16x8 f0 = frag_rm(IMG(B_GT), wave, 0, lane), f1 = frag_rm(IMG(B_GT), wave, 1, lane);
            f32x4 aU = {0.f, 0.f, 0.f, 0.f};
            RWC_MMA(aU, l0, f0); store_tile(IMG(B_GT), wave, 0, lane, aU);
            f0 = frag_rm(IMG(B_GT), wave, 0, lane); aU = (f32x4){0.f, 0.f, 0.f, 0.f};
            RWC_MMA(aU, l1, f0); RWC_MMA(aU, w10, f0); store_tile(IMG(B_GT), wave, 1, lane, aU);
            f0 = frag_rm(IMG(B_GT), wave, 0, lane); aU = (f32x4){0.f, 0.f, 0.f, 0.f};
            RWC_MMA(aU, l2, f1); RWC_MMA(aU, w20, f0); store_tile(IMG(B_GT), wave, 2, lane, aU);
            f1 = frag_rm(IMG(B_GT), wave, 1, lane); aU = (f32x4){0.f, 0.f, 0.f, 0.f};
            RWC_MMA(aU, l3, f1); RWC_MMA(aU, w30, f0); RWC_MMA(aU, w31, f1); store_tile(IMG(B_GT), wave, 3, lane, aU);
        }
        if (more) {
        if (wave >= 4) {
            const int ib = wave - 4;
#pragma unroll
            for (int jb = 0; jb < 4; ++jb) {
                f32x4 aC = {0.f, 0.f, 0.f, 0.f};
#pragma unroll
                for (int s = 0; s < 2; ++s) { RWC_MMA(aC, frag_tr(IMG(B_EH), jb, s, lane), ltf[s]); RWC_MMA(aC, frag_tr(IMG(B_EL), jb, s, lane), ltf[s]); }
                *(LAS f32x4*)(cum + (16 * ib + li) * 64 + 16 * jb + 4 * lg) = aC;
            }
        }
        }
        LDS_BARRIER();
        {
            const int ib = tib[0];
            f32x4 aY[2] = {{0.f, 0.f, 0.f, 0.f}, {0.f, 0.f, 0.f, 0.f}};
#pragma unroll
            for (int s = 0; s < 2; ++s) {
                const bf16x8 frb = frag_rm(IMG(B_RB), ib, s, lane), fp1 = frag_rm(IMG(B_P1), ib, s, lane), fp2 = frag_rm(IMG(B_P2), ib, s, lane), fgi = frag_rm(IMG(B_GT), ib, s, lane), fvi = frag_tr(IMG(B_VT), ib, s, lane);
#pragma unroll
                for (int u = 0; u < 2; ++u) { const int jb = tjb[u];
                    const bf16x8 fvm_j = frag_tr(IMG(B_VT), jb, s, lane);
                    RWC_MMA(aY[u], frag_rm(s_cur, jb, s, lane), frb);
                    RWC_MMA(aY[u], frag_rm(IMG(B_GT), jb, s, lane), fp1);
                    RWC_MMA(aY[u], fvm_j, fp2);
                    RWC_MMA(accS[u], frag_tr(IMG(B_BT), jb, s, lane), fgi);
                    RWC_MMA(accS[u], frag_tr(IMG(B_KT), jb, s, lane), fvi); }
            }
#pragma unroll
            for (int u = 0; u < 2; ++u) { const int jb = tjb[u];
                store_tile(IMG(B_XA), ib, jb, lane, aY[u]);
                const f32x4 ge = *(const LAS f32x4*)(gend + 16 * jb + 4 * lg);
                accS[u] = accS[u] * ge;
                store_tile(s_nxt, ib, jb, lane, accS[u]); }
        }
        LDS_BARRIER();
        {
            const size_t m = mb + (size_t)ch * 64 + et;
            const v4u yw = *(const LAS v4u*)(IMG(B_XA) + (et * PITCH + ec0) * 2), vw = *(const LAS v4u*)(IMG(B_VT) + (et * PITCH + ec0) * 2);
            const float bs = bonus[(ch & 1) * 64 + et];
            float y[8], vv[8], g[8]; float sm = 0.f;
#pragma unroll
            for (int j = 0; j < 4; ++j) { y[2 * j] = bflo(yw[j]); y[2 * j + 1] = bfhi(yw[j]); vv[2 * j] = bflo(vw[j]); vv[2 * j + 1] = bfhi(vw[j]); g[2 * j] = bflo(gw[j]); g[2 * j + 1] = bfhi(gw[j]); }
#pragma unroll
            for (int j = 0; j < 8; ++j) sm += y[j];
            sm = sum8(sm);
            const float mean = sm * (1.0f / 64.0f); float vs = 0.f;
#pragma unroll
            for (int j = 0; j < 8; ++j) { const float dl = y[j] - mean; vs += dl * dl; }
            vs = sum8(vs);
            const float rstd = __builtin_amdgcn_rsqf(vs * (1.0f / 64.0f) + 64e-5f);
            float o[8];
#pragma unroll
            for (int j = 0; j < 8; ++j) o[j] = ((y[j] - mean) * rstd * cst[8 * 64 + ec0 + j] + cst[9 * 64 + ec0 + j] + bs * vv[j]) * g[j];
            *(GAS v4u*)(yout + m * ypitch + h * 64 + ec0) = (v4u){pk2(o[0], o[1]), pk2(o[2], o[3]), pk2(o[4], o[5]), pk2(o[6], o[7])};
        }
        gw = gwn;
        if (more) {
         {
            const f32x4 c0v = *(const LAS f32x4*)(cum + et * 64 + ec0), c1v = *(const LAS f32x4*)(cum + et * 64 + ec0 + 4);
            unsigned wab[4], wbt[4], wkt[4], wrb[4], wvt[4]; float gi8[8];
#pragma unroll
            for (int j = 0; j < 8; j += 2) {
                float va[2], vb[2], vk[2], vr[2];
#pragma unroll
                for (int q = 0; q < 2; ++q) { const float ci = (j + q) < 4 ? c0v[(j + q) & 3] : c1v[(j + q) & 3];
                    const float gi = __expf(-ci), ginv = __expf(ci), ge = __expf(o_ew[j + q] - ci);
                    gi8[j + q] = gi; va[q] = o_al[j + q] * ge; vb[q] = o_be[j + q] * ginv; vk[q] = o_kf[j + q] * ginv; vr[q] = o_r[j + q] * gi; }
                wab[j >> 1] = attn_body::cvtpk_s(va[0], va[1]); wbt[j >> 1] = attn_body::cvtpk_s(vb[0], vb[1]); wkt[j >> 1] = attn_body::cvtpk_s(vk[0], vk[1]);
                wrb[j >> 1] = attn_body::cvtpk_s(vr[0], vr[1]); wvt[j >> 1] = attn_body::cvtpk_s(o_v[j], o_v[j + 1]);
            }
            const int eo = (et * PITCH + ec0) * 2;
            *(LAS v4u*)(IMG(B_AB) + eo) = (v4u){wab[0], wab[1], wab[2], wab[3]}; *(LAS v4u*)(IMG(B_BT) + eo) = (v4u){wbt[0], wbt[1], wbt[2], wbt[3]};
            *(LAS v4u*)(IMG(B_KT) + eo) = (v4u){wkt[0], wkt[1], wkt[2], wkt[3]}; *(LAS v4u*)(IMG(B_RB) + eo) = (v4u){wrb[0], wrb[1], wrb[2], wrb[3]};
            *(LAS v4u*)(IMG(B_VT) + eo) = (v4u){wvt[0], wvt[1], wvt[2], wvt[3]};
            if (et == 63) { *(LAS f32x4*)(gend + ec0) = (f32x4){gi8[0], gi8[1], gi8[2], gi8[3]}; *(LAS f32x4*)(gend + ec0 + 4) = (f32x4){gi8[4], gi8[5], gi8[6], gi8[7]}; }
        }
        }
        LDS_BARRIER();
    }
#undef IMG
    __syncthreads();
}
#ifndef MOE_ALIGN
#define MOE_ALIGN true
#endif
#ifndef ATTN_VAR1
#define ATTN_VAR1 0
#endif
struct Args { const float* in[30]; float* out; unsigned char* ws; int ph_lo, ph_hi, li, pad; };
__global__ void __launch_bounds__(NWAVES * 64, 2) mk_fwd(Args args) {
    extern __shared__ __attribute__((aligned(16))) unsigned char lds[];
    Frame F;
    F.lds = (LAS unsigned char*)lds;
    F.MISC = (volatile LAS unsigned*)(F.lds + MISC_OFF);
    F.tid = threadIdx.x; F.lane = F.tid & 63; F.wave = __builtin_amdgcn_readfirstlane(F.tid >> 6);
    F.G = gridDim.x; { const int bx = blockIdx.x; F.vcu = (F.G % 8 == 0) ? (bx % 8) * (F.G / 8) + bx / 8 : bx; }
    F.ws = args.ws; F.out = args.out; F.ctl = (unsigned*)(args.ws + WS_CTL);
    F.in = (in_tab_t)(args.in); F.z = 0;
    for (int u = F.tid; u < (LDS_BYTES - LDSCTL_OFF) / 4; u += NWAVES * 64) ((LAS unsigned*)(F.lds + LDSCTL_OFF))[u] = 0u;
    __syncthreads();
    const int lo = args.ph_lo, hi = args.ph_hi;
    XcdBarrier bar; bar.bar = F.ctl + CW_BAR + args.li * XCD_BAR_WORDS; bar.x = 0; bar.st = nullptr;
    if (hi - lo > 1) bar = xcd_barrier_post(F.ctl + CW_BAR + args.li * XCD_BAR_WORDS, F.MISC + 8, F.tid);
#ifndef PH_MASK
#define PH_MASK 0xfff
#endif
#define IN(k) ((((PH_MASK) >> (k)) & 1) && lo <= (k) && (k) < hi)
#define SEAM(k) do { if (IN(k) && IN((k) + 1)) { asm volatile("" : "+v"(F.tid)); xcd_barrier(bar, F.tid); } } while (0)
    bf16* const pbuf = (bf16*)(F.ws + WS_P);

    if (IN(0)) { LAUNDER(F); p0_prologue(F); SEAM(0); }
    if (IN(1)) { LAUNDER(F); p1_norm1(F); SEAM(1); }
    if (IN(2)) { LAUNDER(F);
#if P2F8 == 0
        pg8::Gemm g{(const bf16*)(F.ws + WS_H), (const bf16*)(F.ws + WS_WIN), D, 0}; pg8::StaticOrder S; S.init(T / 256, NP / 256, F.G, (int)blockIdx.x);
        pg8::EpiBf16K E{pbuf, NP, 1.0f, F.in[19 + F.z], 9};
        pg8::gemm_phase<pg8::EpiBf16K, pg8::StaticOrder, false>(F.lds, g, S, E, nullptr, F.tid);
#elif P2F8 == 3
        pg8::Gemm g{(const bf16*)(F.ws + WS_H8), (const bf16*)(F.ws + WS_WIN8), D, 0}; pg8::StaticOrder S; S.init(T / 256, NP / 256, F.G, (int)blockIdx.x);
        pg8::EpiBf16K E{pbuf, NP, 1.0f / (H_SCALE * W_SCALE), F.in[19 + F.z], 9};
        pg8::gemm_phase<pg8::EpiBf16K, pg8::StaticOrder, false, true>(F.lds, g, S, E, nullptr, F.tid);
#else
        constexpr int T8_LO = P2F8 == 1 ? 0 : 7, T8_N = P2F8 == 1 ? 7 : 8, TB_LO = P2F8 == 1 ? 7 : 0, TB_N = 15 - T8_N;
        { pg8::Gemm g{(const bf16*)(F.ws + WS_H8), (const bf16*)((const unsigned char*)(F.ws + WS_WIN8) + (size_t)T8_LO * 256 * D), D, 0}; pg8::StaticOrder S; S.init(T / 256, T8_N, F.G, (int)blockIdx.x);
          pg8::EpiBf16 E{pbuf + T8_LO * 256, NP, nullptr, 0, 1.0f / (H_SCALE * W_SCALE)};
          pg8::gemm_phase<pg8::EpiBf16, pg8::StaticOrder, false, true>(F.lds, g, S, E, nullptr, F.tid); }
        __syncthreads();
        { pg8::Gemm g{(const bf16*)(F.ws + WS_H), (const bf16*)(F.ws + WS_WIN) + (size_t)TB_LO * 256 * D, D, 0}; pg8::StaticOrder S; S.init(T / 256, TB_N, F.G, (int)blockIdx.x);
          pg8::EpiBf16 E{pbuf + TB_LO * 256, NP, nullptr, 0, 1.0f};
          pg8::gemm_phase<pg8::EpiBf16, pg8::StaticOrder, false>(F.lds, g, S, E, nullptr, F.tid); }
#endif
        SEAM(2);
    }
    if (IN(3)) { LAUNDER(F); p3_prep(F); SEAM(3); }
    if (IN(4)) { LAUNDER(F);
        pg8::Gemm g{(const bf16*)(F.ws + WS_ALORA), (const bf16*)(F.ws + WS_WLORA), KLORA, 0}; pg8::StaticOrder S; S.init(T / 256, NLORA / 256, F.G, (int)blockIdx.x);
        pg8::EpiBf16 E{(bf16*)(F.ws + WS_LORA), NLORA, nullptr, 0, 1.0f};
        pg8::gemm_phase<pg8::EpiBf16, pg8::StaticOrder, false>(F.lds, g, S, E, nullptr, F.tid);
        SEAM(4);
    }
    if (IN(5)) { LAUNDER(F);
        #ifdef RWKV_SEQ
        if (!(args.pad & 1)) for (int u = F.vcu; u < BATCH * 8; u += F.G) rwkv_unit(F, u);
#else
        if (!(args.pad & 1)) for (int u = F.vcu; u < BATCH * 8; u += F.G) rwkv_unit_chunked(F, u, (bf16*)(F.ws + WS_H), D, args.pad);
#endif
#ifdef RWC_CMP
        for (int u = F.vcu; u < BATCH * 8; u += F.G) {
            bf16* ychk = (bf16*)(F.ws + 960 * MiB);
            rwkv_unit_chunked(F, u, ychk, 512);
            __syncthreads();
            float e2 = 0.f, r2 = 0.f; const int bq = u >> 3, hq = u & 7;
            for (int idx = F.tid; idx < RWC_CMP * 64; idx += NWAVES * 64) { const size_t m = (size_t)bq * SEQ + RWC_CMP0 + (idx >> 6); const int c = hq * 64 + (idx & 63);
                const float a = bflo(((const bf16*)(F.ws + WS_H))[m * D + c]), bb = bflo(ychk[m * 512 + c]); e2 += (a - bb) * (a - bb); r2 += a * a; }
            e2 = wave_sum(e2); r2 = wave_sum(r2);
#if !defined(RWC_CHKX) && !defined(RWC_CHKL)
            if (F.lane == 0) { atomicAdd((float*)(F.ctl + 600), e2); atomicAdd((float*)(F.ctl + 601), r2); }
#endif
        }
#endif
#ifdef DUP_RWKV
        for (int u = F.vcu; u < BATCH * 8; u += F.G) rwkv_unit_chunked(F, u, (bf16*)(F.ws + WS_H), D, 0);
#endif
        if (!(args.pad & 2)) {
        __syncthreads();
        int cur_bh = -1;
        const attn_body::bf16* pb = (const attn_body::bf16*)pbuf;
        for (int ui = F.vcu; ui < BATCH * 8 * (SEQ / 256); ui += F.G) {
            const int bh = ui & 255, qb = ui >> 8;
            if (bh != cur_bh) { __syncthreads();
                fox_bias_table(F, bh, (LAS float*)(F.lds + attn_body::LDS_BIAS), (LAS float*)(F.lds + attn_body::LDS_WS));
                cur_bh = bh; __syncthreads(); }
            attn_body::attn_unit<8, ATTN_VAR1>(bh >> 3, bh & 7, qb, pb + 1792, pb + 2304, pb + 2816, pb + 3328, F.in[20 + F.z], F.in[18 + F.z], (attn_body::bf16*)(F.ws + WS_H) + 512, (char*)lds, F.tid);
        }
        }
#ifdef DUP_ATTN
        if (!(args.pad & 2)) {
        __syncthreads();
        int cur_bh = -1;
        const attn_body::bf16* pb = (const attn_body::bf16*)pbuf;
        for (int ui = F.vcu; ui < BATCH * 8 * (SEQ / 256); ui += F.G) {
            const int bh = ui & 255, qb = ui >> 8;
            if (bh != cur_bh) { __syncthreads();
                fox_bias_table(F, bh, (LAS float*)(F.lds + attn_body::LDS_BIAS), (LAS float*)(F.lds + attn_body::LDS_WS));
                cur_bh = bh; __syncthreads(); }
            attn_body::attn_unit<8>(bh >> 3, bh & 7, qb, pb + 1792, pb + 2304, pb + 2816, pb + 3328, F.in[20 + F.z], F.in[18 + F.z], (attn_body::bf16*)(F.ws + WS_H) + 512, (char*)lds, F.tid);
        }
        }
#endif
        SEAM(5);
    }
    if (IN(6)) { LAUNDER(F);
        pg8::Gemm g{(const bf16*)(F.ws + WS_H), (const bf16*)(F.ws + WS_WOUT), D, 0}; pg8::StaticOrder S; S.init(T / 256, D / 256, F.G, (int)blockIdx.x);
        pg8::EpiResGate E{F.in[0 + F.z], (bf16*)(F.ws + WS_X1), D, (const float*)(F.ws + WS_MOD) + 2048, 6144, SEQ / 256};
        pg8::gemm_phase<pg8::EpiResGate, pg8::StaticOrder, false>(F.lds, g, S, E, nullptr, F.tid);
        SEAM(6);
    }
    if (IN(7)) { LAUNDER(F);
        const int nblk7 = T / 16, per7 = (nblk7 + F.G - 1) / F.G;
        if (per7 * F.G == nblk7 && SEQ % (per7 * 16) == 0) p5_norm2_router_w(F, per7); else p5_norm2_router(F, args.pad);
        SEAM(7); }
    if (IN(8)) { LAUNDER(F); p6_positions(F); SEAM(8); }
    if (IN(9)) { LAUNDER(F);
        const int NB = moe_tables(F);
        pg8::MoeOrder S; S.so.init(NB, 2 * DE / 256, F.G, (int)blockIdx.x); S.blk2e = (const LAS unsigned char*)(F.lds + BLK2E_OFF);
        LAS unsigned short* rowtab = (LAS unsigned short*)(F.lds + AUX_OFF);
        { const LAS unsigned short* blkvalid = (const LAS unsigned short*)(F.lds + BLKVALID_OFF); const int* stok = (const int*)(F.ws + WS_STOK);
          int nun = 0; { pg8::Unit u; while (nun < ROWTAB_UNITS && S.next(nun, u)) ++nun; }
          for (int q = F.tid; q < nun * 256; q += NWAVES * 64) { pg8::Unit u; S.next(q >> 8, u); const int r = q & 255; const int rr = r < (int)blkvalid[u.pm] ? r : 0; rowtab[q] = (unsigned short)stok[u.pm * 256 + rr]; }
          __syncthreads(); }
        pg8::Gemm g{(const bf16*)(F.ws + WS_H2), (const bf16*)(F.ws + WS_WGU), D, (size_t)2 * DE * D};
        pg8::EpiSwigluFp8 E{(unsigned char*)(F.ws + WS_ACT), DE, F.in[26 + F.z], 2 * DE, DE, 1.0f / (H2_SCALE * W_SCALE), ACT_SCALE};
        pg8::gemm_phase<pg8::EpiSwigluFp8, pg8::MoeOrder, true, true, MOE_ALIGN>(F.lds, g, S, E, rowtab, F.tid);
        SEAM(9);
    }
    if (IN(10)) { LAUNDER(F);
        const int NB = moe_tables(F);
        pg8::MoeOrder S; S.so.init(NB, D / 256, F.G, (int)blockIdx.x); S.blk2e = (const LAS unsigned char*)(F.lds + BLK2E_OFF);
        pg8::Gemm g{(const bf16*)(F.ws + WS_ACT), (const bf16*)(F.ws + WS_WD), DE, (size_t)DE * D};
        pg8::EpiFp8 E{(unsigned char*)(F.ws + WS_YS), D, F.in[28 + F.z], D, 1.0f / (ACT_SCALE * W_SCALE), YS_SCALE};
        pg8::gemm_phase<pg8::EpiFp8, pg8::MoeOrder, false, true, MOE_ALIGN>(F.lds, g, S, E, nullptr, F.tid);
        SEAM(10);
    }
    if (IN(11)) { LAUNDER(F); p9_combine(F); }
#undef IN
#undef SEAM
}

extern "C" void kernel_launch(void* const* d_in, const int* in_sizes, int n_in, void* d_out, int out_size, void* d_ws, size_t ws_size, hipStream_t stream) {
    static int grid = 0;
    if (grid == 0) {
        if (n_in != 30 || out_size != T * D || ws_size < WS_END) { fprintf(stderr, "kernel_launch: unexpected problem (n_in %d, out %d, ws %zu)\n", n_in, out_size, ws_size); grid = -1; return; }
        int dev = 0, cus = 0;
        if (hipGetDevice(&dev) != hipSuccess || hipDeviceGetAttribute(&cus, hipDeviceAttributeMultiprocessorCount, dev) != hipSuccess) { grid = -1; return; }
        if (hipFuncSetAttribute((const void*)mk_fwd, hipFuncAttributeMaxDynamicSharedMemorySize, LDS_BYTES) != hipSuccess) { fprintf(stderr, "kernel_launch: hipFuncSetAttribute failed\n"); grid = -1; return; }
        int per_cu = 0;
        if (hipOccupancyMaxActiveBlocksPerMultiprocessor(&per_cu, (const void*)mk_fwd, NWAVES * 64, LDS_BYTES) != hipSuccess || per_cu < 1) fprintf(stderr, "kernel_launch: occupancy query reports %d\n", per_cu);
        (void)hipGetLastError();
        grid = cus;
    }
    if (grid < 0) return;
    if (hipMemsetAsync((char*)d_ws + WS_CTL, 0, CTL_ZERO_BYTES, stream) != hipSuccess) return;
    Args a{};
    for (int i = 0; i < 30; ++i) a.in[i] = (const float*)d_in[i];
    a.out = (float*)d_out; a.ws = (unsigned char*)d_ws; a.pad = 0;
    constexpr int NL = MK_N_LAUNCHES;
    for (int li = 0; li < NL; ++li) {
        a.ph_lo = (NL == 1) ? 0 : li; a.ph_hi = (NL == 1) ? N_PHASES : li + 1; a.li = li;
        hipLaunchKernelGGL(mk_fwd, dim3(grid), dim3(NWAVES * 64), LDS_BYTES, stream, a);
    }
#ifdef PROBE_PHASE
    a.ph_lo = PROBE_PHASE; a.ph_hi = PROBE_PHASE + 1; a.li = 1;
#ifdef PROBE_FLAGS
    a.pad = PROBE_FLAGS;
#endif
    hipLaunchKernelGGL(mk_fwd, dim3(grid), dim3(NWAVES * 64), LDS_BYTES, stream, a);
#endif
}
```

```cpp
#include <hip/hip_runtime.h>
#include <hip/hip_bf16.h>
#include <cstdio>
#include <cstdint>
#include <cmath>
namespace pg8 {
#define PG8_LAS __attribute__((address_space(3)))
typedef unsigned short bf16_t;
typedef short bf16x8 __attribute__((ext_vector_type(8)));
typedef float f32x4 __attribute__((ext_vector_type(4)));
typedef float f32x2 __attribute__((ext_vector_type(2)));
typedef unsigned u32x4 __attribute__((ext_vector_type(4)));
typedef unsigned u32x2 __attribute__((ext_vector_type(2)));
typedef int i32x4 __attribute__((ext_vector_type(4)));
typedef int i32x8 __attribute__((ext_vector_type(8)));
constexpr int BM = 256, BK = 64, HALF = 128, HTB = HALF * BK * 2  , STAGE_BYTES = 8 * HTB, NXCD = 8, WGM = 8;

__host__ __device__ __forceinline__ int lds_byte(int r, int c) { const int st = (r >> 4) * 2 + (c >> 5), rr = r & 15, cc = c & 31, ob = rr * 64 + cc * 2; return st * 1024 + (ob ^ (((ob >> 9) & 1) << 5)); }
__host__ __device__ __forceinline__ void stage_rc(int b, int& R, int& C) { const int st = b / 1024, sb = b % 1024, swz = sb ^ (((sb >> 9) & 1) << 5); R = (st >> 1) * 16 + swz / 64; C = (st & 1) * 32 + (swz % 64) / 2; }
__host__ __device__ __forceinline__ int perm32(int rho) { const int n = rho >> 4, i = rho & 15; return 8 * (i >> 2) + 4 * n + (i & 3); }

struct Unit { int pm, pn, e; };
struct Gemm { const bf16_t* A; const bf16_t* Bt; int K; size_t bstride; };

struct StaticOrder {
    int nM, nN, nwg, G, c;
    __device__ __forceinline__ void init(int nM_, int nN_, int G_, int c_) { nM = nM_; nN = nN_; nwg = nM * nN; G = G_; c = c_; }
    __device__ __forceinline__ bool next(int i, Unit& u) const {
        const long L = (long)i * G + c; if (L >= nwg) return false;
        int wgid = (int)L; { const int q = nwg / NXCD, r = nwg % NXCD, xcd = wgid % NXCD, off = wgid / NXCD; wgid = (xcd < r ? xcd * (q + 1) : r * (q + 1) + (xcd - r) * q) + off; }
        const int nig = WGM * nN, gid = wgid / nig, fm = gid * WGM, gsz = (nM - fm) < WGM ? (nM - fm) : WGM;
        u.pm = fm + ((wgid % nig) % gsz); u.pn = (wgid % nig) / gsz; u.e = 0; return true;
    }
};
struct MoeOrder {
    StaticOrder so; const PG8_LAS unsigned char* blk2e;
    __device__ __forceinline__ bool next(int i, Unit& u) const { if (!so.next(i, u)) return false; u.e = blk2e[u.pm]; return true; }
};

__device__ __forceinline__ unsigned cvt_pk_bf16(float lo, float hi) { unsigned r; asm volatile("v_cvt_pk_bf16_f32 %0, %1, %2" : "=v"(r) : "v"(lo), "v"(hi)); return r; }

struct EpiBf16 {
    static constexpr bool PERM = true;
    struct Pre {}; __device__ __forceinline__ Pre pre(const Unit&, int, int) const { return Pre{}; }
    bf16_t* O; int ldc; const float* bias; int bias_stride; float scale;
    template <class PreT> __device__ __forceinline__ void operator()(const f32x4 (&acc)[2][2][4][2], const Unit& u, int wr, int wc, int fr, int fq, const PreT& P_) const {
        const int row0 = u.pm * BM + wr * 64 + fr; const int col0 = u.pn * BM + wc * 32 + 8 * fq;
        f32x4 bv[2][2];
#pragma unroll
        for (int bj = 0; bj < 2; ++bj)
#pragma unroll
            for (int n = 0; n < 2; ++n) bv[bj][n] = bias ? *(const f32x4*)(bias + (size_t)u.e * bias_stride + col0 + bj * HALF + 4 * n) : (f32x4){0.f, 0.f, 0.f, 0.f};
#pragma unroll
        for (int ai = 0; ai < 2; ++ai)
#pragma unroll
            for (int m = 0; m < 4; ++m) { bf16_t* rowp = O + (size_t)(row0 + ai * HALF + m * 16) * ldc + col0;
#pragma unroll
                for (int bj = 0; bj < 2; ++bj) { const f32x4 v0 = acc[ai][bj][m][0] * scale + bv[bj][0], v1 = acc[ai][bj][m][1] * scale + bv[bj][1];
                    u32x4 w; w.x = cvt_pk_bf16(v0[0], v0[1]); w.y = cvt_pk_bf16(v0[2], v0[3]); w.z = cvt_pk_bf16(v1[0], v1[1]); w.w = cvt_pk_bf16(v1[2], v1[3]);
                    *(u32x4*)(rowp + bj * HALF) = w; } }
    }
};
struct EpiBf16K {
    static constexpr bool PERM = true;
    struct Pre {}; __device__ __forceinline__ Pre pre(const Unit&, int, int) const { return Pre{}; }
    bf16_t* O; int ldc; float scale; const float* kg; int kt0;
    template <class PreT> __device__ __forceinline__ void operator()(const f32x4 (&acc)[2][2][4][2], const Unit& u, int wr, int wc, int fr, int fq, const PreT& P_) const {
        const int row0 = u.pm * BM + wr * 64 + fr;
        if (u.pn == kt0 || u.pn == kt0 + 1) {
            f32x4 g[2][2];
#pragma unroll
            for (int bj = 0; bj < 2; ++bj)
#pragma unroll
                for (int n = 0; n < 2; ++n) g[bj][n] = *(const f32x4*)(kg + 32 * bj + 8 * fq + 4 * n);
#pragma unroll
            for (int ai = 0; ai < 2; ++ai)
#pragma unroll
                for (int m = 0; m < 4; ++m) { bf16_t* rowp = O + (size_t)(row0 + ai * HALF + m * 16) * ldc + u.pn * BM + 64 * wc + 8 * fq;
                    f32x4 v[2][2]; float ss = 0.f;
#pragma unroll
                    for (int bj = 0; bj < 2; ++bj)
#pragma unroll
                        for (int n = 0; n < 2; ++n) { v[bj][n] = acc[ai][bj][m][n] * scale; ss += (v[bj][n][0] * v[bj][n][0] + v[bj][n][1] * v[bj][n][1]) + (v[bj][n][2] * v[bj][n][2] + v[bj][n][3] * v[bj][n][3]); }
                    { auto rr = __builtin_amdgcn_permlane16_swap(__float_as_uint(ss), __float_as_uint(ss), false, false); ss = __uint_as_float(rr[0]) + __uint_as_float(rr[1]); }
                    { auto rr = __builtin_amdgcn_permlane32_swap(__float_as_uint(ss), __float_as_uint(ss), false, false); ss = __uint_as_float(rr[0]) + __uint_as_float(rr[1]); }
                    const float rk = __builtin_amdgcn_rsqf(ss * (1.0f / 64.0f) + 1e-6f);
#pragma unroll
                    for (int bj = 0; bj < 2; ++bj) { const f32x4 v0 = v[bj][0] * rk * g[bj][0], v1 = v[bj][1] * rk * g[bj][1];
                        u32x4 w; w.x = cvt_pk_bf16(v0[0], v0[1]); w.y = cvt_pk_bf16(v0[2], v0[3]); w.z = cvt_pk_bf16(v1[0], v1[1]); w.w = cvt_pk_bf16(v1[2], v1[3]);
                        *(u32x4*)(rowp + 32 * bj) = w; } }
        } else {
            const int col0 = u.pn * BM + wc * 32 + 8 * fq;
#pragma unroll
            for (int ai = 0; ai < 2; ++ai)
#pragma unroll
                for (int m = 0; m < 4; ++m) { bf16_t* rowp = O + (size_t)(row0 + ai * HALF + m * 16) * ldc + col0;
#pragma unroll
                    for (int bj = 0; bj < 2; ++bj) { const f32x4 v0 = acc[ai][bj][m][0] * scale, v1 = acc[ai][bj][m][1] * scale;
                        u32x4 w; w.x = cvt_pk_bf16(v0[0], v0[1]); w.y = cvt_pk_bf16(v0[2], v0[3]); w.z = cvt_pk_bf16(v1[0], v1[1]); w.w = cvt_pk_bf16(v1[2], v1[3]);
                        *(u32x4*)(rowp + bj * HALF) = w; } }
        }
    }
};
struct EpiResGate {
    static constexpr bool PERM = true;
    struct Pre {}; __device__ __forceinline__ Pre pre(const Unit&, int, int) const { return Pre{}; }
    const float* base; bf16_t* out; int ldc; const float* gate; int gate_stride; int pm_per_b;
    template <class PreT> __device__ __forceinline__ void operator()(const f32x4 (&acc)[2][2][4][2], const Unit& u, int wr, int wc, int fr, int fq, const PreT& P_) const {
        const int row0 = u.pm * BM + wr * 64 + fr; const int col0 = u.pn * BM + wc * 32 + 8 * fq;
        const float* gp = gate + (size_t)(u.pm / pm_per_b) * gate_stride + col0;
        f32x4 gv[2][2];
#pragma unroll
        for (int bj = 0; bj < 2; ++bj)
#pragma unroll
            for (int n = 0; n < 2; ++n) gv[bj][n] = *(const f32x4*)(gp + bj * HALF + 4 * n);
#pragma unroll
        for (int ai = 0; ai < 2; ++ai)
#pragma unroll
            for (int m = 0; m < 4; ++m) { const size_t off = (size_t)(row0 + ai * HALF + m * 16) * ldc + col0;
#pragma unroll
                for (int bj = 0; bj < 2; ++bj) { const f32x4 v0 = *(const f32x4*)(base + off + bj * HALF) + gv[bj][0] * acc[ai][bj][m][0], v1 = *(const f32x4*)(base + off + bj * HALF + 4) + gv[bj][1] * acc[ai][bj][m][1];
                    u32x4 w; w.x = cvt_pk_bf16(v0[0], v0[1]); w.y = cvt_pk_bf16(v0[2], v0[3]); w.z = cvt_pk_bf16(v1[0], v1[1]); w.w = cvt_pk_bf16(v1[2], v1[3]);
                    *(u32x4*)(out + off + bj * HALF) = w; } }
    }
};
struct EpiSwiglu {
    static constexpr bool PERM = true;
    struct Pre {}; __device__ __forceinline__ Pre pre(const Unit&, int, int) const { return Pre{}; }
    bf16_t* O; int ldc; const float* bias; int bias_stride;
    int de;
    template <class PreT> __device__ __forceinline__ void operator()(const f32x4 (&acc)[2][2][4][2], const Unit& u, int wr, int wc, int fr, int fq, const PreT& P_) const {
        const int row0 = u.pm * BM + wr * 64 + fr; const int col0 = u.pn * HALF + wc * 32 + 8 * fq;
        const float* bp = bias + (size_t)u.e * bias_stride + col0;
        f32x4 bg[2], bu[2];
#pragma unroll
        for (int n = 0; n < 2; ++n) { bg[n] = *(const f32x4*)(bp + 4 * n); bu[n] = *(const f32x4*)(bp + de + 4 * n); }
#pragma unroll
        for (int ai = 0; ai < 2; ++ai)
#pragma unroll
            for (int m = 0; m < 4; ++m) { bf16_t* rowp = O + (size_t)(row0 + ai * HALF + m * 16) * ldc + col0;
                float r[8];
#pragma unroll
                for (int n = 0; n < 2; ++n) { const f32x4 g4 = acc[ai][0][m][n] + bg[n], u4 = acc[ai][1][m][n] + bu[n];
#pragma unroll
                    for (int i = 0; i < 4; ++i) { const float g = fminf(g4[i], 7.0f), uu = fminf(fmaxf(u4[i], -7.0f), 7.0f);
                        const float sg = __builtin_amdgcn_rcpf(1.0f + __builtin_amdgcn_exp2f(-1.702f * 1.4426950408889634f * g));
                        r[4 * n + i] = g * sg * (uu + 1.0f); } }
                u32x4 w; w.x = cvt_pk_bf16(r[0], r[1]); w.y = cvt_pk_bf16(r[2], r[3]); w.z = cvt_pk_bf16(r[4], r[5]); w.w = cvt_pk_bf16(r[6], r[7]);
                *(u32x4*)rowp = w; }
    }
};

__device__ __forceinline__ unsigned pk4_fp8(float a, float b, float c, float d) {
    int r = __builtin_amdgcn_cvt_pk_fp8_f32(__builtin_amdgcn_fmed3f(a, -448.f, 448.f), __builtin_amdgcn_fmed3f(b, -448.f, 448.f), 0, false);
    r = __builtin_amdgcn_cvt_pk_fp8_f32(__builtin_amdgcn_fmed3f(c, -448.f, 448.f), __builtin_amdgcn_fmed3f(d, -448.f, 448.f), r, true); return (unsigned)r; }
struct EpiSwigluFp8 {
    static constexpr bool PERM = true;
    struct Pre { f32x4 bg[2]; };
    __device__ __forceinline__ Pre pre(const Unit& u, int wc, int fq) const { Pre p; const float* bp = bias + (size_t)u.e * bias_stride + u.pn * HALF + wc * 32 + 8 * fq;
#pragma unroll
        for (int n = 0; n < 2; ++n) p.bg[n] = *(const f32x4*)(bp + 4 * n);
        return p; }
    unsigned char* O; int ldc; const float* bias; int bias_stride; int de; float iscale, oscale;
    template <class PreT> __device__ __forceinline__ void operator()(const f32x4 (&acc)[2][2][4][2], const Unit& u, int wr, int wc, int fr, int fq, const PreT& P_) const {
        const int row0 = u.pm * BM + wr * 64 + fr; const int col0 = u.pn * HALF + wc * 32 + 8 * fq;
        const float* bp = bias + (size_t)u.e * bias_stride + col0;
        f32x4 bg[2], bu[2];
#pragma unroll
        for (int n = 0; n < 2; ++n) { bg[n] = P_.bg[n]; bu[n] = *(const f32x4*)(bp + de + 4 * n); }
        const float c1 = -1.702f * 1.4426950408889634f, os = oscale;
#pragma unroll
        for (int ai = 0; ai < 2; ++ai)
#pragma unroll
            for (int mp = 0; mp < 4; mp += 2) { unsigned wq[2][2];
#pragma unroll
              for (int mq = 0; mq < 2; ++mq) { const int m = mp + mq; unsigned w[2];
#pragma unroll
                for (int n = 0; n < 2; ++n) { const f32x4 g4 = acc[ai][0][m][n] * iscale + bg[n], u4 = acc[ai][1][m][n] * iscale + bu[n];
                    typedef float f32x2v __attribute__((ext_vector_type(2)));
                    float r[4];
#pragma unroll
                    for (int i = 0; i < 4; i += 2) {
                        const f32x2v g = {fminf(g4[i], 7.0f), fminf(g4[i + 1], 7.0f)};
                        const f32x2v um = {__builtin_amdgcn_fmed3f(u4[i], -7.0f, 7.0f), __builtin_amdgcn_fmed3f(u4[i + 1], -7.0f, 7.0f)};
                        const f32x2v uo = um * os + os;
                        const f32x2v t = g * c1;
                        const f32x2v den = (f32x2v){__builtin_amdgcn_exp2f(t.x), __builtin_amdgcn_exp2f(t.y)} + 1.0f;
                        const f32x2v sg = {__builtin_amdgcn_rcpf(den.x), __builtin_amdgcn_rcpf(den.y)};
                        const f32x2v rr = (g * sg) * uo;
                        r[i] = rr.x; r[i + 1] = rr.y; }
                    int pk = __builtin_amdgcn_cvt_pk_fp8_f32(r[0], r[1], 0, false); pk = __builtin_amdgcn_cvt_pk_fp8_f32(r[2], r[3], pk, true); w[n] = (unsigned)pk; }
                wq[mq][0] = w[0]; wq[mq][1] = w[1]; }
                { auto r0_ = __builtin_amdgcn_permlane16_swap(wq[0][0], wq[1][0], false, false), r1_ = __builtin_amdgcn_permlane16_swap(wq[0][1], wq[1][1], false, false);
                  unsigned char* rowp = O + (size_t)(row0 + ai * HALF + (mp + (fq & 1)) * 16) * ldc + col0 - 8 * (fq & 1);
                  *(u32x4*)rowp = (u32x4){r0_[0], r1_[0], r0_[1], r1_[1]}; } }
    }
};

struct EpiFp8 {
    static constexpr bool PERM = true;
    struct Pre {}; __device__ __forceinline__ Pre pre(const Unit&, int, int) const { return Pre{}; }
    unsigned char* O; int ldc; const float* bias; int bias_stride; float scale, oscale;
    template <class PreT> __device__ __forceinline__ void operator()(const f32x4 (&acc)[2][2][4][2], const Unit& u, int wr, int wc, int fr, int fq, const PreT& P_) const {
        const int row0 = u.pm * BM + wr * 64 + fr; const int col0 = u.pn * BM + wc * 32 + 8 * fq;
        f32x4 bv[2][2];
#pragma unroll
        for (int bj = 0; bj < 2; ++bj)
#pragma unroll
            for (int n = 0; n < 2; ++n) bv[bj][n] = *(const f32x4*)(bias + (size_t)u.e * bias_stride + col0 + bj * HALF + 4 * n) * oscale;
        const float sc = scale * oscale;
#pragma unroll
        for (int ai = 0; ai < 2; ++ai)
#pragma unroll
            for (int mp = 0; mp < 4; mp += 2) {
                unsigned char* rowp = O + (size_t)(row0 + ai * HALF + (mp + (fq & 1)) * 16) * ldc + col0 - 8 * (fq & 1);
#pragma unroll
                for (int bj = 0; bj < 2; ++bj) { unsigned wq[2][2];
#pragma unroll
                    for (int mq = 0; mq < 2; ++mq) { const f32x4 v0 = acc[ai][bj][mp + mq][0] * sc + bv[bj][0], v1 = acc[ai][bj][mp + mq][1] * sc + bv[bj][1];
                        wq[mq][0] = pk4_fp8(v0[0], v0[1], v0[2], v0[3]); wq[mq][1] = pk4_fp8(v1[0], v1[1], v1[2], v1[3]); }
                    auto r0_ = __builtin_amdgcn_permlane16_swap(wq[0][0], wq[1][0], false, false), r1_ = __builtin_amdgcn_permlane16_swap(wq[0][1], wq[1][1], false, false);
                    *(u32x4*)(rowp + bj * HALF) = (u32x4){r0_[0], r1_[0], r0_[1], r1_[1]}; } }
    }
};

template <class Epi, class Sched, bool GATHER, bool FP8 = false, bool ALIGN_EPI = true>
__device__ __forceinline__ void gemm_phase(PG8_LAS unsigned char* lds, const Gemm g, const Sched& S, const Epi& E, const PG8_LAS unsigned short* rowtab, const int tid) {
    const int wid = __builtin_amdgcn_readfirstlane(tid >> 6), lane = tid & 63, wr = wid >> 2, wc = wid & 3, fr = lane & 15, fq = lane >> 4;
    constexpr int ES = FP8 ? 1 : 2;
    const int K = g.K, nt = K * ES / (BK * 2);
    unsigned voffB[2]; int RA[2], CA[2];
#pragma unroll
    for (int i = 0; i < 2; ++i) { int R, C; stage_rc(tid * 16 + i * 8192, R, C); const int Rb = Epi::PERM ? ((R & ~31) + perm32(R & 31)) : R;
        RA[i] = R; CA[i] = C; voffB[i] = (unsigned)(Rb * K * ES + C * 2); }
    const size_t kstep = (size_t)(BK * 2);
    const size_t hstep = (size_t)HALF * K * ES;
    const size_t tstep = 2 * hstep;
    const unsigned ldsw = (unsigned)wid * 1024u;
    const int aoff = lds_byte(wr * 64 + fr, fq * 8), boff = lds_byte(wc * 32 + fr, fq * 8);
#define PG8_SA(b, h) (((b) * 2 + (h)) * HTB)
#define PG8_SB(b, h) ((4 + (b) * 2 + (h)) * HTB)
#define PG8_STAGE(bufoff, gbase, voff) do { _Pragma("unroll") for (int _i = 0; _i < 2; ++_i) \
        __builtin_amdgcn_global_load_lds((const unsigned*)((const char*)(gbase) + (voff)[_i]), (PG8_LAS unsigned*)(lds + (bufoff) + ldsw + _i * 8192), 16, 0, 0); } while (0)
#define PG8_LDA(dst, b, h) do { _Pragma("unroll") for (int m = 0; m < 4; ++m) { const i32x4 lo_ = *(const PG8_LAS i32x4*)(lds + PG8_SA(b, h) + aoff + m * 2048), hi_ = *(const PG8_LAS i32x4*)(lds + PG8_SA(b, h) + aoff + m * 2048 + 1024); \
        dst[m] = __builtin_shufflevector(lo_, hi_, 0, 1, 2, 3, 4, 5, 6, 7); } } while (0)
#define PG8_LDB(dst, b, h) do { _Pragma("unroll") for (int n = 0; n < 2; ++n) { const i32x4 lo_ = *(const PG8_LAS i32x4*)(lds + PG8_SB(b, h) + boff + n * 2048), hi_ = *(const PG8_LAS i32x4*)(lds + PG8_SB(b, h) + boff + n * 2048 + 1024); \
        dst[n] = __builtin_shufflevector(lo_, hi_, 0, 1, 2, 3, 4, 5, 6, 7); } } while (0)
#define PG8_LO4(x) __builtin_bit_cast(bf16x8, __builtin_shufflevector(x, x, 0, 1, 2, 3))
#define PG8_HI4(x) __builtin_bit_cast(bf16x8, __builtin_shufflevector(x, x, 4, 5, 6, 7))
#define PG8_MMA(ai, bj, At, Bt) do { __builtin_amdgcn_s_setprio(1); _Pragma("unroll") for (int m = 0; m < 4; ++m) _Pragma("unroll") for (int n = 0; n < 2; ++n) { \
        if constexpr (FP8) asm volatile("v_mfma_f32_16x16x128_f8f6f4 %0, %1, %2, %0" : "+v"(acc[ai][bj][m][n]) : "v"(Bt[n]), "v"(At[m]));   \
        else { acc[ai][bj][m][n] = __builtin_amdgcn_mfma_f32_16x16x32_bf16(PG8_LO4(Bt[n]), PG8_LO4(At[m]), acc[ai][bj][m][n], 0, 0, 0); \
               acc[ai][bj][m][n] = __builtin_amdgcn_mfma_f32_16x16x32_bf16(PG8_HI4(Bt[n]), PG8_HI4(At[m]), acc[ai][bj][m][n], 0, 0, 0); } } \
        __builtin_amdgcn_s_setprio(0); } while (0)
#define PG8_WAIT_V(n) asm volatile("s_waitcnt vmcnt(" #n ")" ::: "memory")
#define PG8_WAIT_L(n) asm volatile("s_waitcnt lgkmcnt(" #n ")" ::: "memory")
#define PG8_BAR __builtin_amdgcn_s_barrier()
#define PG8_SCHED __builtin_amdgcn_sched_barrier(0)
#define PG8_AOFFS(dst0, dst1, u, uidx) do { _Pragma("unroll") for (int _i = 0; _i < 2; ++_i) { \
        if constexpr (GATHER) { const int r0_ = (int)rowtab[(uidx) * BM + RA[_i]], r1_ = (int)rowtab[(uidx) * BM + HALF + RA[_i]]; \
            dst0[_i] = (unsigned)(r0_ * K * ES + CA[_i] * 2); dst1[_i] = (unsigned)(r1_ * K * ES + CA[_i] * 2); } \
        else { dst0[_i] = (unsigned)(((u).pm * BM + RA[_i]) * K * ES + CA[_i] * 2); dst1[_i] = (unsigned)(((u).pm * BM + HALF + RA[_i]) * K * ES + CA[_i] * 2); } } } while (0)
    Unit cur, nxt; int ui = 0;
    if (!S.next(0, cur)) return;
    f32x4 acc[2][2][4][2];
#pragma unroll
    for (int a = 0; a < 2; ++a)
#pragma unroll
        for (int b = 0; b < 2; ++b)
#pragma unroll
            for (int m = 0; m < 4; ++m)
#pragma unroll
                for (int n = 0; n < 2; ++n) acc[a][b][m][n] = (f32x4){0.f, 0.f, 0.f, 0.f};
    i32x8 At[4], B0[2], B1[2];
    const char* const gA = (const char*)g.A;
    unsigned cA0[2], cA1[2], nA0[2], nA1[2];
    PG8_AOFFS(cA0, cA1, cur, 0);
    const char* cB = (const char*)g.Bt + ((size_t)cur.e * g.bstride) * ES + (size_t)cur.pn * tstep;
    PG8_STAGE(PG8_SB(0, 0), cB, voffB); PG8_STAGE(PG8_SB(0, 1), cB + hstep, voffB); PG8_STAGE(PG8_SA(0, 0), gA, cA0); PG8_STAGE(PG8_SA(0, 1), gA, cA1);
    if (wr == 1) PG8_BAR;
    PG8_WAIT_V(2); PG8_BAR;
    PG8_STAGE(PG8_SB(1, 0), cB + kstep, voffB); PG8_STAGE(PG8_SA(1, 0), gA + kstep, cA0); PG8_STAGE(PG8_SB(1, 1), cB + hstep + kstep, voffB);
    PG8_WAIT_V(6); PG8_BAR;
    for (;;) {
        const bool has_next = S.next(ui + 1, nxt);
        const char* nB = has_next ? (const char*)g.Bt + ((size_t)nxt.e * g.bstride) * ES + (size_t)nxt.pn * tstep : cB;
        if (has_next) { PG8_AOFFS(nA0, nA1, nxt, ui + 1); } else { nA0[0] = cA0[0]; nA0[1] = cA0[1]; nA1[0] = cA1[0]; nA1[1] = cA1[1]; }
        typename Epi::Pre epre;
#pragma nounroll
        for (int t = 0; t < nt; t += 2) {
            const bool last = (t == nt - 2);
            if (last) epre = E.pre(cur, wc, fq);
            const char* a1 = gA + (size_t)(t + 1) * kstep;
            const char* a2 = last ? gA : gA + (size_t)(t + 2) * kstep; const char* b2 = last ? nB : cB + (size_t)(t + 2) * kstep;
            const char* a3 = a2 + kstep; const char* b3 = b2 + kstep;
            unsigned xA0[2], xA1[2];
            xA0[0] = last ? nA0[0] : cA0[0]; xA0[1] = last ? nA0[1] : cA0[1]; xA1[0] = last ? nA1[0] : cA1[0]; xA1[1] = last ? nA1[1] : cA1[1];
            PG8_LDB(B0, 0, 0); PG8_LDB(B1, 0, 1); PG8_SCHED; PG8_LDA(At, 0, 0); PG8_STAGE(PG8_SA(1, 1), a1, cA1);
            PG8_WAIT_V(8); PG8_WAIT_L(0); PG8_BAR; PG8_MMA(0, 0, At, B0); PG8_MMA(0, 1, At, B1); PG8_BAR; PG8_SCHED;
            PG8_LDA(At, 0, 1); PG8_STAGE(PG8_SB(0, 0), b2, voffB); PG8_STAGE(PG8_SB(0, 1), b2 + hstep, voffB); PG8_STAGE(PG8_SA(0, 0), a2, xA0);
            PG8_WAIT_V(8); PG8_WAIT_L(0); PG8_BAR; PG8_MMA(1, 0, At, B0); PG8_MMA(1, 1, At, B1); PG8_BAR; PG8_SCHED;
            PG8_LDB(B0, 1, 0); PG8_LDB(B1, 1, 1); PG8_SCHED; PG8_LDA(At, 1, 0); PG8_STAGE(PG8_SA(0, 1), a2, xA1);
            PG8_WAIT_V(8); PG8_WAIT_L(0); PG8_BAR; PG8_MMA(0, 0, At, B0); PG8_MMA(0, 1, At, B1); PG8_BAR; PG8_SCHED;
            PG8_LDA(At, 1, 1); PG8_STAGE(PG8_SB(1, 0), b3, voffB); PG8_STAGE(PG8_SB(1, 1), b3 + hstep, voffB); PG8_STAGE(PG8_SA(1, 0), a3, xA0);
            PG8_WAIT_V(8); PG8_WAIT_L(0); PG8_BAR; PG8_MMA(1, 0, At, B0); PG8_MMA(1, 1, At, B1); PG8_BAR; PG8_SCHED;
        }
        if constexpr (ALIGN_EPI) if (wr == 0) PG8_BAR;
        if constexpr (FP8) asm volatile("s_nop 15\n\ts_nop 7" ::: "memory");
        E(acc, cur, wr, wc, fr, fq, epre);
        if (!has_next) break;
#pragma unroll
        for (int a = 0; a < 2; ++a)
#pragma unroll
            for (int b = 0; b < 2; ++b)
#pragma unroll
                for (int m = 0; m < 4; ++m)
#pragma unroll
                    for (int n = 0; n < 2; ++n) acc[a][b][m][n] = (f32x4){0.f, 0.f, 0.f, 0.f};
        cur = nxt; cB = nB; cA0[0] = nA0[0]; cA0[1] = nA0[1]; cA1[0] = nA1[0]; cA1[1] = nA1[1]; ++ui;
        if constexpr (ALIGN_EPI) if (wr == 1) PG8_BAR;
    }
    PG8_WAIT_V(0);
    if constexpr (!ALIGN_EPI) { if (wr == 0) PG8_BAR; }
    PG8_BAR;
#undef PG8_SA
#undef PG8_SB
#undef PG8_STAGE
#undef PG8_LDA
#undef PG8_LDB
#undef PG8_MMA
#undef PG8_LO4
#undef PG8_HI4
#undef PG8_WAIT_V
#undef PG8_WAIT_L
#undef PG8_BAR
#undef PG8_SCHED
#undef PG8_AOFFS
}
}
namespace attn_body {
using bf16=__hip_bfloat16;
using bf16x8=__attribute__((ext_vector_type(8)))short;
using s16x4=__attribute__((ext_vector_type(4)))short;
using f32x16=__attribute__((ext_vector_type(16)))float;
using u32x4=__attribute__((ext_vector_type(4)))unsigned;
using f32x4v=__attribute__((ext_vector_type(4)))float;
constexpr int BATCH=32,NHEAD=8,SEQ=2048,D=64,DM=3840,DMO=1024;
constexpr int NW=8,QBLK=32,QB=QBLK*NW,KVBLK=64,NQB=SEQ/QB;
constexpr int ATTN_UNIT_ROWS=QB;
__device__ __forceinline__ int crow(int r,int hi){return (r&3)+8*(r>>2)+4*hi;}
#define SBAR() __builtin_amdgcn_sched_barrier(0)
__device__ __forceinline__ void cmask(f32x16&p0,f32x16&p1,int jb,int qrel,int hi){
  const float NEG=-INFINITY; int kb=64*jb+4*hi;
  #pragma unroll
  for(int r=0;r<16;++r){int kv=kb+(r&3)+8*(r>>2); if(kv>qrel)p0[r]=NEG; if(kv+32>qrel)p1[r]=NEG;}
}

constexpr int NSLOT=3, SLOTB=8192;
constexpr int LDS_K=0, LDS_V=NSLOT*SLOTB, LDS_WS=2*NSLOT*SLOTB, LDS_OST=LDS_WS+NW*64*4, LDS_BIAS=LDS_OST+NW*4096, LDS_BYTES=LDS_BIAS+SEQ*4;
constexpr float C2=0.125f*1.4426950408889634f;
__device__ __forceinline__ void glds16(const void*gsrc,unsigned lds_dst){unsigned keep;
  asm volatile("s_mov_b32 %0, m0\n\ts_mov_b32 m0, %2\n\ts_nop 0\n\tglobal_load_lds_dwordx4 %1, off\n\ts_mov_b32 m0, %0":"=&s"(keep):"v"(gsrc),"s"(lds_dst):"memory");}
__device__ __forceinline__ float max3f(float a,float b,float c){float r;asm("v_max3_f32 %0, %1, %2, %3":"=v"(r):"v"(a),"v"(b),"v"(c));return r;}
__device__ __forceinline__ float max2f(float a,float b){float r;asm("v_max_f32_e32 %0, %1, %2":"=v"(r):"v"(a),"v"(b));return r;}
__device__ __forceinline__ float fadd_s(float a,float b){float r;asm("v_add_f32_e32 %0, %1, %2":"=v"(r):"v"(a),"v"(b));return r;}
__device__ __forceinline__ float fsub_s(float a,float b){float r;asm("v_sub_f32_e32 %0, %1, %2":"=v"(r):"v"(a),"v"(b));return r;}
typedef float f32x2_t __attribute__((ext_vector_type(2))); typedef __bf16 bf16x2_t __attribute__((ext_vector_type(2)));
__device__ __forceinline__ unsigned cvtpk_s(float lo,float hi){f32x2_t v={lo,hi};bf16x2_t b=__builtin_convertvector(v,bf16x2_t);return __builtin_bit_cast(unsigned,b);}
#define WAIT_BAR(N) asm volatile("s_waitcnt vmcnt(" #N ") lgkmcnt(0)\n\ts_barrier":::"memory")

__device__ __forceinline__ void qkt(f32x16&p0,f32x16&p1,const char*Kslot,const bf16x8*qr,int r32,int hi){
  const char*kb=Kslot+hi*1024+r32*16;
  #pragma unroll
  for(int d0=0;d0<4;++d0){
    const bf16x8 b0=*reinterpret_cast<const bf16x8*>(kb+d0*2048);
    const bf16x8 b1=*reinterpret_cast<const bf16x8*>(kb+d0*2048+512);
    p0=__builtin_amdgcn_mfma_f32_32x32x16_bf16(b0,qr[d0],p0,0,0,0);p1=__builtin_amdgcn_mfma_f32_32x32x16_bf16(b1,qr[d0],p1,0,0,0);}
}
typedef __attribute__((address_space(3))) const char* lds_cptr;
typedef short v4i16_t __attribute__((ext_vector_type(4)));
__device__ __forceinline__ void kload8(bf16x8*kf,lds_cptr kp){
  kf[0]=*(const __attribute__((address_space(3))) bf16x8*)(kp);      kf[1]=*(const __attribute__((address_space(3))) bf16x8*)(kp+512);
  kf[2]=*(const __attribute__((address_space(3))) bf16x8*)(kp+2048); kf[3]=*(const __attribute__((address_space(3))) bf16x8*)(kp+2560);
  kf[4]=*(const __attribute__((address_space(3))) bf16x8*)(kp+4096); kf[5]=*(const __attribute__((address_space(3))) bf16x8*)(kp+4608);
  kf[6]=*(const __attribute__((address_space(3))) bf16x8*)(kp+6144); kf[7]=*(const __attribute__((address_space(3))) bf16x8*)(kp+6656);
}
__device__ __forceinline__ void kload2(bf16x8*kf,lds_cptr kp,int j){ kf[2*j]=*(const __attribute__((address_space(3))) bf16x8*)(kp+j*2048); kf[2*j+1]=*(const __attribute__((address_space(3))) bf16x8*)(kp+j*2048+512); }
__device__ __forceinline__ s16x4 vtr(lds_cptr p){ return __builtin_bit_cast(s16x4,__builtin_amdgcn_ds_read_tr16_b64_v4i16((__attribute__((address_space(3))) v4i16_t*)p)); }
__device__ __forceinline__ float rowmax(const f32x16&p0,const f32x16&p1){
  float a=max3f(p0[0],p0[1],p1[0]),b=max3f(p0[2],p0[3],p1[1]);a=max3f(a,p1[2],p1[3]);
  #pragma unroll
  for(int r=4;r<16;r+=4){a=max3f(a,p0[r],p0[r+1]);b=max3f(b,p0[r+2],p0[r+3]);a=max3f(a,p1[r],p1[r+1]);b=max3f(b,p1[r+2],p1[r+3]);}
  const float m=max2f(a,b);
  auto rr=__builtin_amdgcn_permlane32_swap(__float_as_uint(m),__float_as_uint(m),false,false);
  return max2f(__uint_as_float(rr[0]),__uint_as_float(rr[1]));
}
__device__ __forceinline__ void pv(f32x16*o,int vb,bf16x8 pa0,bf16x8 pa1,bf16x8 pa2,bf16x8 pa3){
  #pragma unroll
  for(int d0=0;d0<2;++d0){s16x4 lo[4],hi[4];
    #pragma unroll
    for(int ks=0;ks<4;++ks){
      asm volatile("ds_read_b64_tr_b16 %0,%1 offset:%c2":"=&v"(lo[ks]):"v"(vb),"i"(d0*4096+ks*1024):"memory");
      asm volatile("ds_read_b64_tr_b16 %0,%1 offset:%c2":"=&v"(hi[ks]):"v"(vb),"i"(d0*4096+ks*1024+512):"memory");}
    asm volatile("s_waitcnt lgkmcnt(0)":::"memory");SBAR();
    #define PK(k) (bf16x8){lo[k][0],lo[k][1],lo[k][2],lo[k][3],hi[k][0],hi[k][1],hi[k][2],hi[k][3]}
    o[d0]=__builtin_amdgcn_mfma_f32_32x32x16_bf16(pa0,PK(0),o[d0],0,0,0);
    o[d0]=__builtin_amdgcn_mfma_f32_32x32x16_bf16(pa1,PK(1),o[d0],0,0,0);
    o[d0]=__builtin_amdgcn_mfma_f32_32x32x16_bf16(pa2,PK(2),o[d0],0,0,0);
    o[d0]=__builtin_amdgcn_mfma_f32_32x32x16_bf16(pa3,PK(3),o[d0],0,0,0);
    #undef PK
  }
}

#ifndef ATTN_STORE16
#define ATTN_STORE16(p,v) (*(u32x4*)(p)=(v))
#endif
template<int THRL,int VAR=0> __device__ __forceinline__ void attn_unit(int b,int h,int qb,const bf16*Q,const bf16*__restrict__ K,const bf16*__restrict__ V,const bf16*__restrict__ OG,const float*__restrict__ GO,const float*__restrict__ GQ,bf16*O,char*shm,const int tid){
  const int lane=tid&63,r32=lane&31,hi=lane>>5; const int wid=__builtin_amdgcn_readfirstlane(tid>>6);
  const long rowbase=(long)b*SEQ; const int q0=qb*QB;
  const bf16*Qw=Q+(rowbase+q0+wid*QBLK)*DM+h*D;
  const bf16*Kh=K+rowbase*DM+h*D,*Vh=V+rowbase*DM+h*D;
  const unsigned lds0=(unsigned)(uintptr_t)shm;
  float*wsf=(float*)(shm+LDS_WS)+wid*64;
  const bf16*ksrc=Kh+(long)lane*DM+wid*8;
  const bf16*vsrc=Vh+(long)(16*(wid&3)+(lane>>2))*DM+(wid>>2)*32+(lane&3)*8;
  const unsigned kdst=lds0+LDS_K+wid*1024, vdst=lds0+LDS_V+wid*1024;
  #define DMA_K(t,slot) glds16(ksrc+(long)(t)*KVBLK*DM,(unsigned)__builtin_amdgcn_readfirstlane(kdst+(slot)))
  #define DMA_V(t,slot) glds16(vsrc+(long)(t)*KVBLK*DM,(unsigned)__builtin_amdgcn_readfirstlane(vdst+(slot)))
  const int vb0=(int)(lds0+LDS_V)+((lane>>4)&1)*32+(lane&3)*8+(4*hi+((lane&15)>>2))*64;
  const char*Kbase=shm+LDS_K; bf16x8 kf[8];
  const lds_cptr shm3=(lds_cptr)shm; const lds_cptr kp0=shm3+LDS_K+hi*1024+r32*16; const lds_cptr vp0=shm3+LDS_V+((lane>>4)&1)*32+(lane&3)*8+(4*hi+((lane&15)>>2))*64;
  const __attribute__((address_space(3))) float*biasl=(const __attribute__((address_space(3))) float*)(shm3+LDS_BIAS)+4*hi;
  const int NT=(q0+QB)/KVBLK;
  DMA_K(0,0);DMA_V(0,0);DMA_K(1,SLOTB);
  bf16x8 qr[4];
  #pragma unroll
  for(int d0=0;d0<4;++d0)qr[d0]=*reinterpret_cast<const bf16x8*>(&Qw[(long)r32*DM+d0*16+hi*8]);
  {
    float qf[32]; float ssq=0.f;
    #pragma unroll
    for(int d0=0;d0<4;++d0){
      #pragma unroll
      for(int j=0;j<8;++j){ qf[8*d0+j]=__uint_as_float(((unsigned)(unsigned short)qr[d0][j])<<16); ssq+=qf[8*d0+j]*qf[8*d0+j]; } }
    { auto rr=__builtin_amdgcn_permlane32_swap(__float_as_uint(ssq),__float_as_uint(ssq),false,false); ssq=__uint_as_float(rr[0])+__uint_as_float(rr[1]); }
    const float rq=__builtin_amdgcn_rsqf(ssq*(1.0f/64.0f)+1e-6f)*C2;
    #pragma unroll
    for(int d0=0;d0<4;++d0){ u32x4 w_;
      #pragma unroll
      for(int j=0;j<4;++j) w_[j]=cvtpk_s(qf[8*d0+2*j]*rq*GQ[d0*16+hi*8+2*j],qf[8*d0+2*j+1]*rq*GQ[d0*16+hi*8+2*j+1]);
      qr[d0]=__builtin_bit_cast(bf16x8,w_); } }
  float mhat=0.f,l_reg=0.f;f32x16 o[2];o[0]=f32x16{};o[1]=f32x16{};
  const int qrel=wid*QBLK+r32;
  mhat=*((const __attribute__((address_space(3))) float*)(shm3+LDS_BIAS)+q0+qrel)+6.0f;
  #define CMASK(P0,P1,t) do{int jb_=(t)-(NT-4); if(jb_>=0)cmask(P0,P1,jb_,qrel,hi);}while(0)
  #define CINIT(P0,P1,t) do{ if constexpr(VAR==1){ _Pragma("unroll") for(int r_=0;r_<16;++r_){ P0[r_]=-mhat; P1[r_]=-mhat; } } else { \
      const __attribute__((address_space(3))) float*bt_=biasl+(t)*KVBLK; const f32x4v nm_={-mhat,-mhat,-mhat,-mhat}; _Pragma("unroll") for(int g_=0;g_<4;++g_){ \
      const f32x4v b0_=*(const __attribute__((address_space(3))) f32x4v*)(bt_+8*g_)+nm_, b1_=*(const __attribute__((address_space(3))) f32x4v*)(bt_+32+8*g_)+nm_; \
      _Pragma("unroll") for(int i_=0;i_<4;++i_){ P0[4*g_+i_]=b0_[i_]; P1[4*g_+i_]=b1_[i_]; } } } }while(0)
  bool resc=false;
  #define START(P0,P1) do{ const float rm=rowmax(P0,P1); resc=false; \
    { const float dl=rm>(float)THRL?rm:0.f; mhat=fadd_s(mhat,dl); \
      _Pragma("unroll") for(int r=0;r<16;++r){P0[r]=fsub_s(P0[r],dl);P1[r]=fsub_s(P1[r],dl);} \
      } \
    _Pragma("unroll") for(int r=0;r<16;++r)P0[r]=__builtin_amdgcn_exp2f(P0[r]); }while(0)
  #define RESC() do{ if(resc){ asm volatile("s_waitcnt lgkmcnt(0)":::"memory"); \
      _Pragma("unroll") for(int d_=0;d_<2;++d_) _Pragma("unroll") for(int r=0;r<16;++r)o[d_][r]*=wsf[crow(r,hi)]; } }while(0)
  f32x16 pA0,pA1,pB0,pB1;
  int sl_prev=0,sl_cur=0,sl_next=SLOTB;
  #define ROT() do{sl_prev=sl_cur;sl_cur=sl_next;sl_next=(sl_next==(NSLOT-1)*SLOTB)?0:sl_next+SLOTB;}while(0)
  DMA_K(2,2*SLOTB);
  WAIT_BAR(3);
  CINIT(pA0,pA1,0);qkt(pA0,pA1,Kbase,qr,r32,hi);asm volatile("s_nop 15\n\ts_nop 7":"+v"(pA0),"+v"(pA1));CMASK(pA0,pA1,0);
  START(pA0,pA1);
  _Pragma("unroll") for(int r=0;r<16;++r)pA1[r]=__builtin_amdgcn_exp2f(pA1[r]);
  WAIT_BAR(0);
  DMA_K(3,0);DMA_V(1,SLOTB);
  ROT();
  kload8(kf,kp0+sl_cur);
  WAIT_BAR(2);
  s16x4 vlo[8],vhi[8]; u32x4 pw0,pw1,pw2,pw3;
  #define PKW(P,B) cvtpk_s(P[B],P[B+1])
  #define PAF(k) __builtin_bit_cast(bf16x8,pw##k)
  #define VFR(i) (bf16x8){vlo[i][0],vlo[i][1],vlo[i][2],vlo[i][3],vhi[i][0],vhi[i][1],vhi[i][2],vhi[i][3]}
  #define PIN(x) asm volatile("":"+v"(x))
  #define MX3(a,b,c) __builtin_fmaxf(__builtin_fmaxf((a),(b)),(c))
  #define GAPA(MF,A0,A1,A2,A3,W0,W1,PW) do{ MF; sacc+=A0; sacc+=A1; sacc+=A2; sacc+=A3; PIN(sacc); W0; W1; PIN(PW); SBAR(); }while(0)
  #define EX(v) __builtin_amdgcn_exp2f(v)
  #define GAPB(MF,X,B) do{ MF; X[B]=EX(X[B]); X[B+1]=EX(X[B+1]); X[B+2]=EX(X[B+2]); X[B+3]=EX(X[B+3]); PIN(X); SBAR(); }while(0)
  #define VRD(i) do{ vlo[i]=vtr(vp_+(((i)>>2)*4096+((i)&3)*1024)); vhi[i]=vtr(vp_+(((i)>>2)*4096+((i)&3)*1024+512)); }while(0)
  #define KRD(G,j) do{ if(G){ kload2(kf,kp0+sl_next,j); SBAR(); } }while(0)
  #define STEP(C0,C1,P0,P1,t,GK,GV,GL) do{ CINIT(C0,C1,t); SBAR(); \
    const lds_cptr vp_=vp0+sl_prev; \
    VRD(0); SBAR(); float sacc=(P0[0]+P0[1]); \
    GAPA(C0=__builtin_amdgcn_mfma_f32_32x32x16_bf16(kf[0],qr[0],C0,0,0,0), P0[2],P0[3],P0[4],P0[5],     pw0[0]=PKW(P0,0), pw0[1]=PKW(P0,2), pw0); \
    VRD(4); SBAR(); GAPA(C1=__builtin_amdgcn_mfma_f32_32x32x16_bf16(kf[1],qr[0],C1,0,0,0), P0[6],P0[7],P0[8],P0[9],     pw0[2]=PKW(P0,4), pw0[3]=PKW(P0,6), pw0); \
    VRD(1); SBAR(); GAPA(C0=__builtin_amdgcn_mfma_f32_32x32x16_bf16(kf[2],qr[1],C0,0,0,0),   P0[10],P0[11],P0[12],P0[13], pw1[0]=PKW(P0,8), pw1[1]=PKW(P0,10), pw1); \
    VRD(5); SBAR(); GAPA(C1=__builtin_amdgcn_mfma_f32_32x32x16_bf16(kf[3],qr[1],C1,0,0,0),   P0[14],P0[15],P1[0],P1[1],   pw1[2]=PKW(P0,12),pw1[3]=PKW(P0,14), pw1); \
    VRD(2); SBAR(); GAPA(C0=__builtin_amdgcn_mfma_f32_32x32x16_bf16(kf[4],qr[2],C0,0,0,0),   P1[2],P1[3],P1[4],P1[5],     pw2[0]=PKW(P1,0), pw2[1]=PKW(P1,2), pw2); \
    VRD(6); SBAR(); GAPA(C1=__builtin_amdgcn_mfma_f32_32x32x16_bf16(kf[5],qr[2],C1,0,0,0),   P1[6],P1[7],P1[8],P1[9],     pw2[2]=PKW(P1,4), pw2[3]=PKW(P1,6), pw2); \
    VRD(3); SBAR(); GAPA(C0=__builtin_amdgcn_mfma_f32_32x32x16_bf16(kf[6],qr[3],C0,0,0,0),   P1[10],P1[11],P1[12],P1[13], pw3[0]=PKW(P1,8), pw3[1]=PKW(P1,10), pw3); \
    VRD(7); SBAR(); GAPA(C1=__builtin_amdgcn_mfma_f32_32x32x16_bf16(kf[7],qr[3],C1,0,0,0),   P1[14],P1[15],0.f,0.f,       pw3[2]=PKW(P1,12),pw3[3]=PKW(P1,14), pw3); \
    l_reg+=sacc; \
    if(GK){DMA_K((t)+3,sl_cur);} if(GV){DMA_V((t)+1,sl_next);} \
    CMASK(C0,C1,t); \
    { float a=MX3(C0[0],C0[1],C1[0]),b=MX3(C0[2],C0[3],C1[1]); a=MX3(a,C1[2],C1[3]); \
      _Pragma("unroll") for(int r=4;r<16;r+=4){a=MX3(a,C0[r],C0[r+1]);b=MX3(b,C0[r+2],C0[r+3]);a=MX3(a,C1[r],C1[r+1]);b=MX3(b,C1[r+2],C1[r+3]);} \
      float rm=__builtin_fmaxf(a,b); { auto rr=__builtin_amdgcn_permlane32_swap(__float_as_uint(rm),__float_as_uint(rm),false,false); rm=__builtin_fmaxf(__uint_as_float(rr[0]),__uint_as_float(rr[1])); } \
      resc=false; \
      if(__builtin_expect(__any(rm>(float)THRL),0)){ const float dl=__builtin_fmaxf(rm,0.f); mhat+=dl; \
        _Pragma("unroll") for(int r=0;r<16;++r){C0[r]-=dl;C1[r]-=dl;} \
        const float f=__builtin_amdgcn_exp2f(-dl); l_reg*=f; if(hi==0)wsf[r32]=f; resc=true; } } \
    SBAR(); \
    GAPB(o[0]=__builtin_amdgcn_mfma_f32_32x32x16_bf16(PAF(0),VFR(0),o[0],0,0,0), C0,0); \
    GAPB(o[1]=__builtin_amdgcn_mfma_f32_32x32x16_bf16(PAF(0),VFR(4),o[1],0,0,0), C0,4); \
    KRD(GL,0); GAPB(o[0]=__builtin_amdgcn_mfma_f32_32x32x16_bf16(PAF(1),VFR(1),o[0],0,0,0), C0,8); \
    KRD(GL,1); GAPB(o[1]=__builtin_amdgcn_mfma_f32_32x32x16_bf16(PAF(1),VFR(5),o[1],0,0,0), C0,12); \
    KRD(GL,2); GAPB(o[0]=__builtin_amdgcn_mfma_f32_32x32x16_bf16(PAF(2),VFR(2),o[0],0,0,0), C1,0); \
    KRD(GL,3); GAPB(o[1]=__builtin_amdgcn_mfma_f32_32x32x16_bf16(PAF(2),VFR(6),o[1],0,0,0), C1,4); \
    GAPB(o[0]=__builtin_amdgcn_mfma_f32_32x32x16_bf16(PAF(3),VFR(3),o[0],0,0,0), C1,8); \
    GAPB(o[1]=__builtin_amdgcn_mfma_f32_32x32x16_bf16(PAF(3),VFR(7),o[1],0,0,0), C1,12); \
    }while(0)
  int t=1;
  #undef CMASK
  #define CMASK(P0,P1,t) do{}while(0)
  for(;t+5<NT;t+=2){
    STEP(pB0,pB1,pA0,pA1,t,true,true,true);     WAIT_BAR(2); RESC(); ROT();
    STEP(pA0,pA1,pB0,pB1,t+1,true,true,true);   WAIT_BAR(2); RESC(); ROT();
  }
  #undef CMASK
  #define CMASK(P0,P1,t) do{int jb_=(t)-(NT-4); if(jb_>=0)cmask(P0,P1,jb_,qrel,hi);}while(0)
  #define ENDW(tt) do{ if((tt)+3<NT){WAIT_BAR(2);} else if((tt)+2<NT){WAIT_BAR(1);} else {WAIT_BAR(0);} }while(0)
  for(;t+1<NT;t+=2){
    STEP(pB0,pB1,pA0,pA1,t,(t+3<NT),(t+1<NT),(t+1<NT));       ENDW(t);   RESC(); ROT();
    STEP(pA0,pA1,pB0,pB1,t+1,(t+4<NT),(t+2<NT),(t+2<NT));     ENDW(t+1); RESC(); ROT();
  }
  STEP(pB0,pB1,pA0,pA1,NT-1,false,false,false); RESC();
  { float sacc=pB0[0]+pB0[1]; _Pragma("unroll") for(int r=2;r<16;++r)sacc+=pB0[r]; _Pragma("unroll") for(int r=0;r<16;++r)sacc+=pB1[r]; l_reg+=sacc;
    pw0=(u32x4){PKW(pB0,0),PKW(pB0,2),PKW(pB0,4),PKW(pB0,6)};pw1=(u32x4){PKW(pB0,8),PKW(pB0,10),PKW(pB0,12),PKW(pB0,14)};pw2=(u32x4){PKW(pB1,0),PKW(pB1,2),PKW(pB1,4),PKW(pB1,6)};pw3=(u32x4){PKW(pB1,8),PKW(pB1,10),PKW(pB1,12),PKW(pB1,14)};
    SBAR(); pv(o,vb0+sl_cur,PAF(0),PAF(1),PAF(2),PAF(3)); }
  #undef PKW
  #undef PAF
  #undef VFR
  #undef PIN
  #undef MX3
  #undef GAPA
  #undef GAPB
  #undef EX
  #undef VRD
  #undef KRD
  #undef STEP
  #undef ENDW
  {auto rr=__builtin_amdgcn_permlane32_swap(__float_as_uint(l_reg),__float_as_uint(l_reg),false,false);l_reg=__uint_as_float(rr[0])+__uint_as_float(rr[1]);}
  if(hi==0)wsf[32+r32]=l_reg;asm volatile("s_waitcnt lgkmcnt(0)":::"memory");
  float rli[16];
  #pragma unroll
  for(int r=0;r<16;++r)rli[r]=__builtin_amdgcn_rcpf(wsf[32+crow(r,hi)]);
  bf16*Ow=O+(rowbase+q0+wid*QBLK)*DMO+h*D;
  const bf16*Gw=OG+(rowbase+q0+wid*QBLK)*DM+h*D;
  { bf16*stg=(bf16*)(shm+LDS_OST)+wid*2048;
    #pragma unroll
    for(int r=0;r<16;++r){const int orow=crow(r,hi);
      #pragma unroll
      for(int d0=0;d0<2;++d0)stg[orow*64+d0*32+r32]=__float2bfloat16(o[d0][r]*rli[r]);}
    asm volatile("s_waitcnt lgkmcnt(0)":::"memory");
    const int ch=lane&7; float gov[8];
    #pragma unroll
    for(int j=0;j<8;++j)gov[j]=GO[ch*8+j];
    #pragma unroll
    for(int i=0;i<4;++i){const int row=i*8+(lane>>3); const u32x4 v=*(const u32x4*)(stg+row*64+ch*8); const u32x4 gq=*(const u32x4*)(Gw+(long)row*DM+ch*8);
      float x[8],gg[8];
      #pragma unroll
      for(int j=0;j<4;++j){x[2*j]=__uint_as_float(v[j]<<16);x[2*j+1]=__uint_as_float(v[j]&0xffff0000u);gg[2*j]=__uint_as_float(gq[j]<<16);gg[2*j+1]=__uint_as_float(gq[j]&0xffff0000u);}
      float ss=0.f;
      #pragma unroll
      for(int j=0;j<8;++j)ss+=x[j]*x[j];
      ss+=__shfl_xor(ss,1);ss+=__shfl_xor(ss,2);ss+=__shfl_xor(ss,4);
      const float rs=__builtin_amdgcn_rsqf(ss*(1.0f/64.0f)+1e-6f);
      float y[8];
      #pragma unroll
      for(int j=0;j<8;++j)y[j]=x[j]*rs*gov[j]*__builtin_amdgcn_rcpf(1.0f+__builtin_amdgcn_exp2f(-1.4426950408889634f*gg[j]));
      u32x4 w; w[0]=cvtpk_s(y[0],y[1]);w[1]=cvtpk_s(y[2],y[3]);w[2]=cvtpk_s(y[4],y[5]);w[3]=cvtpk_s(y[6],y[7]);
      ATTN_STORE16(Ow+(long)row*DMO+ch*8,w);} }
  asm volatile("s_waitcnt lgkmcnt(0)\n\ts_barrier":::"memory");
  #undef DMA_K
  #undef DMA_V
  #undef CMASK
  #undef START
  #undef RESC
  #undef ROT
}
constexpr int ATTN_LDS_BYTES=LDS_BYTES;
#undef SBAR
#undef WAIT_BAR
}
constexpr int NWAVES = 8;
constexpr int BATCH = 32, SEQ = 2048, D = 1024, T = BATCH * SEQ;
constexpr int NP = 3840, D_IN = 3848;
constexpr int NE = 32, TOPK = 4, DE = 1024;
constexpr int CAP = T * TOPK + NE * 256;
constexpr int NLORA = 1536, KLORA = 256;
constexpr float LOG2E = 1.4426950408889634f;
constexpr float H2_SCALE = 32.0f, ACT_SCALE = 4.0f, W_SCALE = 256.0f, YS_SCALE = 64.0f;
constexpr int N_PHASES = 12;
#ifndef MK_N_LAUNCHES
#define MK_N_LAUNCHES 1
#endif

constexpr size_t MiB = 1u << 20;
constexpr size_t WS_CTL = 0, CTL_ZERO_BYTES = 1 * MiB;
constexpr size_t WS_MOD = 1 * MiB, WS_LF = 2 * MiB, WS_FB = 4 * MiB, WS_IDX = 6 * MiB, WS_GATE = 7 * MiB, WS_POS = 8 * MiB, WS_STOK = 9 * MiB;
constexpr size_t WS_WLORA = 11 * MiB, WS_WR = 11 * MiB + 768 * 1024, WS_WOUT = 12 * MiB, WS_WIN = 14 * MiB;
constexpr size_t WS_WGU = 32 * MiB, WS_WD = 96 * MiB;
constexpr size_t WS_LORA = 128 * MiB;
#ifndef P2F8
#define P2F8 3
#endif
static_assert(P2F8 == 3 || P2F8 == 0, "the attention keys are head-normalised in the projection GEMM's epilogue: the split settings are no longer complete");
constexpr float H_SCALE = 32.0f;
constexpr size_t WS_WIN8 = 22 * MiB, WS_H8 = 128 * MiB;
constexpr size_t WS_H = 320 * MiB;
constexpr size_t WS_P = 448 * MiB;
constexpr size_t WS_ALORA = 928 * MiB;
constexpr size_t WS_H2 = 128 * MiB, WS_ACT = 192 * MiB, WS_YS = 456 * MiB, WS_X1 = 720 * MiB, WS_END = 984 * MiB;
static_assert(WS_WGU + (size_t)NE * 2 * DE * D <= WS_WD && WS_WD + (size_t)NE * DE * D <= WS_H2 && WS_H2 + (size_t)T * D <= WS_ACT && WS_ACT + (size_t)CAP * DE <= WS_YS && WS_YS + (size_t)CAP * D <= WS_X1 && WS_X1 + (size_t)T * D * 2 <= WS_END, "ws map");
static_assert(WS_LORA + (size_t)T * 1536 * 2 <= WS_H && WS_H + (size_t)T * D * 2 <= WS_P && WS_P + (size_t)T * NP * 2 <= WS_ALORA && WS_ALORA + (size_t)T * 256 * 2 <= WS_END, "ws map (first half of the forward)");
constexpr int CW_BAR = 4096;
constexpr int CW_CNT = 256;
constexpr int CW_CUR = 320;

constexpr int RING_BYTES = 131072;
constexpr int AUX_OFF = RING_BYTES, AUX_BYTES = 30720;
constexpr int ROWTAB_UNITS = 40;
constexpr int BLK2E_OFF = AUX_OFF + ROWTAB_UNITS * 512, BLKVALID_OFF = BLK2E_OFF + 1152;
constexpr int LDSCTL_OFF = AUX_OFF + AUX_BYTES, MISC_OFF = LDSCTL_OFF + 256;
constexpr int LDS_BYTES = 163840;
static_assert(BLKVALID_OFF + 1152 * 2 <= LDSCTL_OFF && MISC_OFF + 256 <= LDS_BYTES && CAP / 256 <= 1152, "LDS map");

#define GAS __attribute__((address_space(1)))
#define LAS __attribute__((address_space(3)))
typedef unsigned short bf16;
typedef unsigned v4u __attribute__((ext_vector_type(4)));
typedef unsigned v2u __attribute__((ext_vector_type(2)));
typedef float f32x4 __attribute__((ext_vector_type(4)));
typedef float f32x2 __attribute__((ext_vector_type(2)));
#define LDS_WAIT() asm volatile("s_waitcnt lgkmcnt(0)" ::: "memory")
#define LDS_BARRIER() asm volatile("s_waitcnt lgkmcnt(0)\n\ts_barrier" ::: "memory")
__device__ __forceinline__ unsigned f2bf(float f) { unsigned u = __builtin_bit_cast(unsigned, f); return (u + 0x7fffu + ((u >> 16) & 1u)) >> 16; }
__device__ __forceinline__ unsigned pk2(float lo, float hi) { return f2bf(lo) | (f2bf(hi) << 16); }
__device__ __forceinline__ float bflo(unsigned w) { return __uint_as_float(w << 16); }
__device__ __forceinline__ float bfhi(unsigned w) { return __uint_as_float(w & 0xffff0000u); }
__device__ __forceinline__ float sigmoidf_(float x) { return 1.0f / (1.0f + __expf(-x)); }

#define XB_TMO      128
#define XB_XCNT(j)  (256  + 64 * (j))
#define XB_XSUB(j)  (1280 + 64 * (j))
#define XB_XGEN(j)  (2304 + 64 * (j))
#define XB_TOP      3328
#define XB_TOPGEN   3392
#define XCD_BAR_WORDS 3456
#define XB_SPIN_CAP (1u << 22)
__device__ __forceinline__ unsigned xb_ld(unsigned* p)              { return __hip_atomic_load(p, __ATOMIC_RELAXED, __HIP_MEMORY_SCOPE_AGENT); }
__device__ __forceinline__ unsigned xb_add(unsigned* p, unsigned v) { return __hip_atomic_fetch_add(p, v, __ATOMIC_RELAXED, __HIP_MEMORY_SCOPE_AGENT); }
__device__ __forceinline__ unsigned xb_xcc_id() { return (unsigned)__builtin_amdgcn_s_getreg((3 << 11) | 20) & 0xFu; }
#define XB_SPIN(cond, bar) do { unsigned _sp = 0; while (cond) { __builtin_amdgcn_s_sleep(1); \
    if ((++_sp & 255u) == 0u) { if (xb_ld(&(bar)[XB_TMO])) break; if (_sp > XB_SPIN_CAP) { atomicAdd(&(bar)[XB_TMO], 1u); break; } } } } while (0)
struct XcdBarrier { unsigned* bar; unsigned x; volatile LAS unsigned* st; };
__device__ __forceinline__ XcdBarrier xcd_barrier_post(unsigned* bar, volatile LAS unsigned* st, const int tid) {
    XcdBarrier b; b.bar = bar; b.x = xb_xcc_id(); b.st = st;
    if (tid == 0) (void)xb_add(&bar[XB_XCNT(b.x)], 1u);
    return b;
}
__device__ __forceinline__ void xcd_barrier_complete(unsigned* bar, unsigned x, unsigned& nloc, unsigned& nx) {
    const unsigned G = gridDim.x * gridDim.y * gridDim.z;
    unsigned sum, cnt, mine, sp = 0u;
    for (;;) {
        sum = 0u; cnt = 0u; mine = 0u;
#pragma unroll
        for (unsigned j = 0; j < 16; ++j) { const unsigned c = xb_ld(&bar[XB_XCNT(j)]); sum += c; cnt += (c > 0u) ? 1u : 0u; mine = (j == x) ? c : mine; }
        if (sum == G) break;
        __builtin_amdgcn_s_sleep(1);
        if ((++sp & 255u) == 0u) { if (xb_ld(&bar[XB_TMO])) break; if (sp > XB_SPIN_CAP) { atomicAdd(&bar[XB_TMO], 1u); break; } }
    }
    nloc = mine > 0u ? mine : 1u; nx = cnt > 0u ? cnt : 1u;
}
__device__ __forceinline__ void xcd_barrier(const XcdBarrier& b, const int tid) {
    asm volatile("s_waitcnt vmcnt(0)" ::: "memory");
    __syncthreads();
    if (tid == 0) {
        unsigned* bar = b.bar;
        __builtin_amdgcn_s_waitcnt(0);
        unsigned nloc = b.st[0], nx = b.st[1];
        if (nloc == 0u) { xcd_barrier_complete(bar, b.x, nloc, nx); b.st[0] = nloc; b.st[1] = nx; }
        const unsigned old = xb_add(&bar[XB_XSUB(b.x)], 1u);
        const unsigned gen = old / nloc;
        if (old + 1u == (gen + 1u) * nloc) {
            __builtin_amdgcn_fence(__ATOMIC_RELEASE, "agent");
            asm volatile("s_waitcnt vmcnt(0)" ::: "memory");
            const unsigned og = xb_add(&bar[XB_TOP], 1u);
            const unsigned tg = og / nx;
            if (og + 1u == (tg + 1u) * nx) xb_add(&bar[XB_TOPGEN], 1u);
            else XB_SPIN(xb_ld(&bar[XB_TOPGEN]) == tg, bar);
            __builtin_amdgcn_fence(__ATOMIC_ACQUIRE, "agent");
            xb_add(&bar[XB_XGEN(b.x)], 1u);
            asm volatile("s_waitcnt vmcnt(0)" ::: "memory");
        } else {
            XB_SPIN(xb_ld(&bar[XB_XGEN(b.x)]) == gen, bar);
            __builtin_amdgcn_fence(__ATOMIC_ACQUIRE, "agent");
            asm volatile("s_waitcnt vmcnt(0)" ::: "memory");
        }
    }
    __syncthreads();
}

typedef const float* cfp_t;
typedef __attribute__((address_space(4))) const cfp_t* in_tab_t;
#define LAUNDER(F) do { asm volatile("s_mov_b32 %0, 0" : "=s"((F).z)); asm volatile("" : "+v"((F).tid)); (F).lane = (F).tid & 63; } while (0)
struct Frame {
    LAS unsigned char* lds;
    volatile LAS unsigned* MISC;
    unsigned* ctl;
    int tid, lane, wave, vcu, G, z;
    in_tab_t in; float* out; unsigned char* ws;
};
#define DPP_F(x, ctrl) __uint_as_float(__builtin_amdgcn_update_dpp(0, __float_as_uint(x), (ctrl), 0xF, 0xF, true))
__device__ __forceinline__ float wave_sum(float v) {
    v += DPP_F(v, 0xB1); v += DPP_F(v, 0x4E); v += DPP_F(v, 0x141); v += DPP_F(v, 0x140);
    { auto rr = __builtin_amdgcn_permlane16_swap(__float_as_uint(v), __float_as_uint(v), false, false); v = __uint_as_float(rr[0]) + __uint_as_float(rr[1]); }
    { auto rr = __builtin_amdgcn_permlane32_swap(__float_as_uint(v), __float_as_uint(v), false, false); v = __uint_as_float(rr[0]) + __uint_as_float(rr[1]); }
    return v;
}
__device__ __forceinline__ float half_max(float v) {
    v = fmaxf(v, DPP_F(v, 0xB1)); v = fmaxf(v, DPP_F(v, 0x4E)); v = fmaxf(v, DPP_F(v, 0x141)); v = fmaxf(v, DPP_F(v, 0x140));
    { auto rr = __builtin_amdgcn_permlane16_swap(__float_as_uint(v), __float_as_uint(v), false, false); v = fmaxf(__uint_as_float(rr[0]), __uint_as_float(rr[1])); }
    return v;
}
__device__ __forceinline__ float sum8(float v) { v += DPP_F(v, 0xB1); v += DPP_F(v, 0x4E); v += DPP_F(v, 0x141); return v; }

__device__ __forceinline__ void tr_item(const float* W, int ldw, int k0, int n0, bf16* WT, int ldo, int orow0, LAS float* scr, int lane) {
    float t_[32];
#pragma unroll
    for (int i = 0; i < 32; ++i) t_[i] = W[(size_t)(k0 + 2 * i + (lane >> 5)) * ldw + n0 + (lane & 31)];
#pragma unroll
    for (int i = 0; i < 32; ++i) scr[(2 * i + (lane >> 5)) * 33 + (lane & 31)] = t_[i];
    LDS_WAIT(); asm volatile("" ::: "memory");
    const int c = lane & 7;
#pragma unroll
    for (int j = 0; j < 4; ++j) { const int n = (lane >> 3) + 8 * j; const LAS float* s = scr + (8 * c) * 33 + n;
        v4u o; o.x = pk2(s[0 * 33], s[1 * 33]); o.y = pk2(s[2 * 33], s[3 * 33]); o.z = pk2(s[4 * 33], s[5 * 33]); o.w = pk2(s[6 * 33], s[7 * 33]);
        *(GAS v4u*)(WT + (size_t)(orow0 + n) * ldo + k0 + 8 * c) = o; }
    LDS_WAIT(); asm volatile("" ::: "memory");
}

__device__ __forceinline__ void tr_item_fp8(const float* W, int ldw, int k0, int n0, unsigned char* WT, int ldo, int orow0, LAS float* scr, int lane, float scale) {
    float t_[32];
#pragma unroll
    for (int i = 0; i < 32; ++i) t_[i] = W[(size_t)(k0 + 2 * i + (lane >> 5)) * ldw + n0 + (lane & 31)];
#pragma unroll
    for (int i = 0; i < 32; ++i) scr[(2 * i + (lane >> 5)) * 33 + (lane & 31)] = t_[i] * scale;
    LDS_WAIT(); asm volatile("" ::: "memory");
    const int c = lane & 7;
#pragma unroll
    for (int j = 0; j < 4; ++j) { const int n = (lane >> 3) + 8 * j; const LAS float* s = scr + (8 * c) * 33 + n;
        v2u o; o.x = pg8::pk4_fp8(s[0 * 33], s[1 * 33], s[2 * 33], s[3 * 33]); o.y = pg8::pk4_fp8(s[4 * 33], s[5 * 33], s[6 * 33], s[7 * 33]);
        *(GAS v2u*)(WT + (size_t)(orow0 + n) * ldo + k0 + 8 * c) = o; }
    LDS_WAIT(); asm volatile("" ::: "memory");
}

struct TrItem { const float* src; unsigned char* dst; int ldw; };
__device__ __forceinline__ void tr_issue(const TrItem& c, float (&t)[32], int lane) {
    const float* s = c.src + (size_t)(lane >> 5) * c.ldw + (lane & 31);
#pragma unroll
    for (int i = 0; i < 32; ++i) t[i] = s[(size_t)(2 * i) * c.ldw];
    asm volatile("" ::: "memory");
}
__device__ __forceinline__ void tr_finish(const TrItem& c, const float (&t)[32], LAS float* scr, int lane, float scale) {
#pragma unroll
    for (int i = 0; i < 32; ++i) scr[(2 * i + (lane >> 5)) * 33 + (lane & 31)] = t[i] * scale;
    LDS_WAIT(); asm volatile("" ::: "memory");
    const int cc = lane & 7;
#pragma unroll
    for (int j = 0; j < 4; ++j) { const int n = (lane >> 3) + 8 * j; const LAS float* s = scr + (8 * cc) * 33 + n;
        v2u o; o.x = pg8::pk4_fp8(s[0 * 33], s[1 * 33], s[2 * 33], s[3 * 33]); o.y = pg8::pk4_fp8(s[4 * 33], s[5 * 33], s[6 * 33], s[7 * 33]);
        *(GAS v2u*)(c.dst + (size_t)n * 1024 + 8 * cc) = o; }
    LDS_WAIT(); asm volatile("" ::: "memory");
}
__device__ __forceinline__ void tr_dma_issue(const TrItem& c, LAS unsigned char* buf, int lane) {
    const char* s = (const char*)c.src + ((size_t)(lane >> 3) * c.ldw + 4 * (lane & 7)) * 4;
    const size_t rs = (size_t)c.ldw * 32;
#pragma unroll
    for (int i = 0; i < 8; ++i) __builtin_amdgcn_global_load_lds((const unsigned*)(s + i * rs), (LAS unsigned*)(buf + i * 1056), 16, 0, 0);
}
__device__ __forceinline__ void tr_dma_finish(const TrItem& c, const LAS unsigned char* buf, int lane, float scale) {
    const int cc = lane & 7;
#pragma unroll
    for (int j = 0; j < 4; ++j) { const int n = (lane >> 3) + 8 * j; const LAS float* s = (const LAS float*)(buf + cc * 1056) + n;
        v2u o; o.x = pg8::pk4_fp8(s[0] * scale, s[32] * scale, s[64] * scale, s[96] * scale); o.y = pg8::pk4_fp8(s[128] * scale, s[160] * scale, s[192] * scale, s[224] * scale);
        *(GAS v2u*)(c.dst + (size_t)n * 1024 + 8 * cc) = o; }
    LDS_WAIT();
}
__device__ __forceinline__ TrItem moe_tr_item(Frame& F, int it) {
    constexpr int I_GU = 32 * 16 * 64; TrItem c;
    if (it < I_GU) { const int e = it >> 10, r = it & 1023, kb = r >> 6, nb = r & 63, n0 = 32 * nb; const int n1 = n0 & 1023;
        const int orow = 256 * (n1 >> 7) + (n0 >= 1024 ? 128 : 0) + (n1 & 127);
        c.src = F.in[25 + F.z] + (size_t)e * 1024 * 2048 + (size_t)(64 * kb) * 2048 + n0; c.dst = (unsigned char*)(F.ws + WS_WGU) + (size_t)e * 2048 * 1024 + (size_t)orow * 1024 + 64 * kb; c.ldw = 2048; }
    else { const int q = it - I_GU, e = q >> 9, r = q & 511, kb = r >> 5, nb = r & 31;
        c.src = F.in[27 + F.z] + (size_t)e * 1024 * 1024 + (size_t)(64 * kb) * 1024 + 32 * nb; c.dst = (unsigned char*)(F.ws + WS_WD) + (size_t)e * 1024 * 1024 + (size_t)(32 * nb) * 1024 + 64 * kb; c.ldw = 1024; }
    return c;
}

__device__ __forceinline__ void p0_prologue(Frame& F) {
    const float* c = F.in[1 + F.z]; const float* w_ada = F.in[2 + F.z]; const float* b_ada = F.in[3 + F.z];
    float* mod = (float*)(F.ws + WS_MOD);
    LAS float* cact = (LAS float*)F.lds;
    for (int cg = F.vcu; cg < 96; cg += F.G) {
        for (int idx = F.tid; idx < 32768; idx += NWAVES * 64) { const int b = idx >> 10, k = idx & 1023; const float v = c[idx]; cact[k * 32 + b] = v / (1.0f + __expf(-v)); }
        __syncthreads();
        float acc[32];
#pragma unroll
        for (int b = 0; b < 32; ++b) acc[b] = 0.f;
        const int col = cg * 64 + F.lane;
        for (int kb = F.wave * 128; kb < F.wave * 128 + 128; kb += 16) {
            float wv[16];
#pragma unroll
            for (int u = 0; u < 16; ++u) wv[u] = w_ada[(size_t)(kb + u) * 6144 + col];
#pragma unroll
            for (int u = 0; u < 16; ++u)
#pragma unroll
                for (int q = 0; q < 8; ++q) { const f32x4 cv = *(const LAS f32x4*)(cact + (kb + u) * 32 + 4 * q);
                    acc[4 * q + 0] += cv[0] * wv[u]; acc[4 * q + 1] += cv[1] * wv[u]; acc[4 * q + 2] += cv[2] * wv[u]; acc[4 * q + 3] += cv[3] * wv[u]; }
        }
        __syncthreads();
        LAS float* red = (LAS float*)F.lds;
#pragma unroll
        for (int b = 0; b < 32; ++b) red[(F.wave * 32 + b) * 64 + F.lane] = acc[b];
        __syncthreads();
        for (int idx = F.tid; idx < 2048; idx += NWAVES * 64) { const int b = idx >> 6, l = idx & 63; float s = b_ada[cg * 64 + l];
#pragma unroll
            for (int w = 0; w < 8; ++w) s += red[(w * 32 + b) * 64 + l];
            mod[(size_t)b * 6144 + cg * 64 + l] = s; }
        __syncthreads();
    }
    LAS float* scr = (LAS float*)(F.lds + F.wave * 16384);
    const int gw = F.vcu * NWAVES + F.wave, NGW = F.G * NWAVES;
    constexpr int I_IN = 16 * 120, I_OUT = 16 * 32;
    for (int it = gw; it < I_IN + I_OUT; it += NGW) {
        if (it < I_IN) { const int kb = it / 120, nb = it % 120;
            if (P2F8 != 3) { int orow = 32 * nb; if (orow >= 2304 && orow < 2816) { const int ct = (orow - 2304) & 255; orow = orow - ct + 128 * ((ct >> 5) & 1) + 32 * (ct >> 6); }
                tr_item(F.in[5 + F.z], D_IN, 64 * kb, 32 * nb, (bf16*)(F.ws + WS_WIN), D, orow, scr, F.lane); }
            if (P2F8 != 0) { int orow = 32 * nb;
                if (P2F8 == 3 && orow >= 2304 && orow < 2816) { const int ct = (orow - 2304) & 255; orow = orow - ct + 128 * ((ct >> 5) & 1) + 32 * (ct >> 6); }
                tr_item_fp8(F.in[5 + F.z], D_IN, 64 * kb, 32 * nb, (unsigned char*)(F.ws + WS_WIN8), D, orow, scr, F.lane, W_SCALE); } }
        else { const int r = it - I_IN, kb = r / 32, nb = r % 32; tr_item(F.in[21 + F.z], D, 64 * kb, 32 * nb, (bf16*)(F.ws + WS_WOUT), D, 32 * nb, scr, F.lane); }
    }
    { constexpr int I_GU = 32 * 16 * 64, I_DN = 32 * 16 * 32;
      const int n_modw = (F.G > 96 ? 96 : F.G) * NWAVES, n_othw = NGW - n_modw; const bool modw = F.vcu < 96;
      const int n_a = n_othw > 0 ? n_modw * 20 : I_GU + I_DN;
      const int it0 = modw ? gw : n_a + (gw - n_modw), it_end = modw ? n_a : I_GU + I_DN, it_step = modw ? n_modw : n_othw;
      __syncthreads();
      LAS unsigned char* bufA = F.lds + __builtin_amdgcn_readfirstlane(F.wave) * 16896; LAS unsigned char* bufB = bufA + 8448;
      TrItem ca, cb;
      if (it0 < it_end) {
          int it = it0; ca = moe_tr_item(F, it); tr_dma_issue(ca, bufA, F.lane);
          while (true) {
              const int i1 = it + it_step; const bool h1 = i1 < it_end;
              if (h1) { cb = moe_tr_item(F, i1); tr_dma_issue(cb, bufB, F.lane); asm volatile("s_waitcnt vmcnt(8)" ::: "memory"); }
              else asm volatile("s_waitcnt vmcnt(0)" ::: "memory");
              tr_dma_finish(ca, bufA, F.lane, W_SCALE);
              if (!h1) break;
              const int i2 = i1 + it_step; const bool h2 = i2 < it_end;
              if (h2) { ca = moe_tr_item(F, i2); tr_dma_issue(ca, bufA, F.lane); asm volatile("s_waitcnt vmcnt(8)" ::: "memory"); }
              else asm volatile("s_waitcnt vmcnt(0)" ::: "memory");
              tr_dma_finish(cb, bufB, F.lane, W_SCALE);
              if (!h2) break;
              it = i2;
          } } }
    { bf16* WR = (bf16*)(F.ws + WS_WR); const float* wr = F.in[23 + F.z];
      for (int idx = gw * 64 + F.lane; idx < 32 * 1024; idx += NGW * 64) { const int e = idx >> 10, k = idx & 1023; const float w = wr[k * 32 + e]; const unsigned hb = f2bf(w);
          WR[idx] = (bf16)hb; WR[32 * 1024 + idx] = (bf16)f2bf(w - __uint_as_float(hb << 16)); } }
    { bf16* WL = (bf16*)(F.ws + WS_WLORA); const float* w2 = F.in[8 + F.z]; const float* a2 = F.in[10 + F.z]; const float* g2 = F.in[11 + F.z];
      for (int idx = gw * 64 + F.lane; idx < NLORA * KLORA; idx += NGW * 64) { const int n = idx >> 8, k = idx & 255; float v = 0.f;
          if (n < 512) { if (k < 64) v = w2[k * 512 + n]; }
          else if (n < 1024) { if (k >= 64 && k < 128) v = a2[(k - 64) * 512 + (n - 512)]; }
          else { if (k >= 128) v = g2[(k - 128) * 512 + (n - 1024)]; }
          WL[idx] = (bf16)f2bf(v); } }
}

__device__ __forceinline__ void p1_norm1(Frame& F) {
    const float* x = F.in[0 + F.z]; const float* g1 = F.in[4 + F.z]; const float* w_in = F.in[5 + F.z]; const float* b_f = F.in[17 + F.z];
    const float* mod = (const float*)(F.ws + WS_MOD); bf16* h = (bf16*)(F.ws + WS_H); float* lf = (float*)(F.ws + WS_LF);
    LAS float* wf = (LAS float*)F.lds;
    for (int idx = F.tid; idx < 8192; idx += NWAVES * 64) wf[idx] = w_in[(size_t)(idx >> 3) * D_IN + NP + (idx & 7)];
    __syncthreads();
    const int gw = F.vcu * NWAVES + F.wave, NGW = F.G * NWAVES;
    for (int rg = gw; rg < T / 32; rg += NGW) {
        const int m0 = rg * 32, b = m0 / SEQ;
        f32x4 cA[4], cB[4];
#pragma unroll
        for (int j = 0; j < 4; ++j) { const int col = 4 * F.lane + 256 * j; const f32x4 g = *(const f32x4*)(g1 + col), sc = *(const f32x4*)(mod + (size_t)b * 6144 + 1024 + col);
            cA[j] = g * (sc + 1.0f); cB[j] = *(const f32x4*)(mod + (size_t)b * 6144 + col); }
        f32x4 nx[4], nx2[4];
        { const GAS f32x4* xr = (const GAS f32x4*)(x + (size_t)m0 * D) + F.lane;
#pragma unroll
          for (int j = 0; j < 4; ++j) { nx[j] = xr[64 * j]; nx2[j] = xr[256 + 64 * j]; } }
        for (int r = 0; r < 32; ++r) {
            const int m = m0 + r;
            f32x4 v[4]; float ss = 0.f;
#pragma unroll
            for (int j = 0; j < 4; ++j) { v[j] = nx[j]; nx[j] = nx2[j]; }
            if (r + 2 < 32) { const GAS f32x4* xr = (const GAS f32x4*)(x + (size_t)(m + 2) * D) + F.lane;
#pragma unroll
                for (int j = 0; j < 4; ++j) nx2[j] = xr[64 * j]; }
#pragma unroll
            for (int j = 0; j < 4; ++j) ss += (v[j].x * v[j].x + v[j].y * v[j].y) + (v[j].z * v[j].z + v[j].w * v[j].w);
            const float rstd = 1.0f / sqrtf(wave_sum(ss) * (1.0f / D) + 1e-6f);
            float fl[8];
#pragma unroll
            for (int q = 0; q < 8; ++q) fl[q] = 0.f;
            GAS v2u* o8 = (GAS v2u*)(h + (size_t)m * D) + F.lane;
            unsigned hw8[4] = {0u, 0u, 0u, 0u};
#pragma unroll
            for (int j = 0; j < 4; ++j) { const f32x4 hv = v[j] * rstd * cA[j] + cB[j];
                if (P2F8 != 3) o8[64 * j] = (v2u){pk2(hv.x, hv.y), pk2(hv.z, hv.w)};
                if (P2F8 != 0) hw8[j] = pg8::pk4_fp8(hv.x * H_SCALE, hv.y * H_SCALE, hv.z * H_SCALE, hv.w * H_SCALE);
#pragma unroll
                for (int i = 0; i < 4; ++i) { const LAS float* wp = wf + (4 * F.lane + 256 * j + i) * 8; const f32x4 w0 = *(const LAS f32x4*)wp, w1 = *(const LAS f32x4*)(wp + 4);
                    fl[0] += hv[i] * w0[0]; fl[1] += hv[i] * w0[1]; fl[2] += hv[i] * w0[2]; fl[3] += hv[i] * w0[3]; fl[4] += hv[i] * w1[0]; fl[5] += hv[i] * w1[1]; fl[6] += hv[i] * w1[2]; fl[7] += hv[i] * w1[3]; } }
            if (P2F8 != 0) {
                const int qi = F.lane & 3;
#pragma unroll
                for (int p = 0; p < 4; p += 2) { const unsigned snd = (qi & 1) ? hw8[p] : hw8[p + 1]; const unsigned r = (unsigned)__builtin_amdgcn_update_dpp(0, (int)snd, 0xB1, 0xF, 0xF, true); if (qi & 1) hw8[p] = r; else hw8[p + 1] = r; }
#pragma unroll
                for (int p = 0; p < 2; ++p) { const unsigned snd = (qi & 2) ? hw8[p] : hw8[p + 2]; const unsigned r = (unsigned)__builtin_amdgcn_update_dpp(0, (int)snd, 0x4E, 0xF, 0xF, true); if (qi & 2) hw8[p] = r; else hw8[p + 2] = r; }
                *(GAS v4u*)((unsigned char*)(F.ws + WS_H8) + (size_t)m * D + 256 * qi + 16 * (F.lane >> 2)) = (v4u){hw8[0], hw8[1], hw8[2], hw8[3]};
            }
            float mine = 0.f;
#pragma unroll
            for (int q = 0; q < 8; ++q) { const float s = wave_sum(fl[q]); if (F.lane == q) mine = s; }
            if (F.lane < 8) { const float z = mine + b_f[F.lane]; lf[(size_t)m * 8 + F.lane] = fminf(z, 0.f) - __logf(1.0f + __expf(-fabsf(z))); }
        }
    }
}

__device__ __forceinline__ void fox_bias_table(Frame& F, int bh, LAS float* tab, LAS float* wsum) {
    const float* lf = (const float*)(F.ws + WS_LF) + ((size_t)(bh >> 3) * SEQ + 4 * F.tid) * 8 + (bh & 7);
    float v[4]; float run = 0.f;
#pragma unroll
    for (int i = 0; i < 4; ++i) { run += lf[8 * i]; v[i] = run; }
    float incl = run;
#pragma unroll
    for (int o = 1; o < 64; o <<= 1) { const float t = __shfl_up(incl, o); if (F.lane >= o) incl += t; }
    if (F.lane == 63) wsum[F.wave] = incl;
    __syncthreads();
    float carry = 0.f;
    for (int w = 0; w < F.wave; ++w) carry += wsum[w];
    const float excl = carry + incl - run;
    *(LAS f32x4*)(tab + 4 * F.tid) = (f32x4){-(excl + v[0]) * LOG2E, -(excl + v[1]) * LOG2E, -(excl + v[2]) * LOG2E, -(excl + v[3]) * LOG2E};
}

__device__ __forceinline__ void p3_prep(Frame& F) {
    bf16* p = (bf16*)(F.ws + WS_P); bf16* alora = (bf16*)(F.ws + WS_ALORA);
    const float* mu = F.in[6 + F.z];
    const int gw = F.vcu * NWAVES + F.wave, NGW = F.G * NWAVES, lane = F.lane;
    float mu4[4];
#pragma unroll
    for (int i = 0; i < 4; ++i) mu4[i] = mu[1536 + 4 * lane + i];
    for (int rg = gw; rg < T / 32; rg += NGW) {
        const int m0 = rg * 32;
        float prev[4] = {0.f, 0.f, 0.f, 0.f};
        if ((m0 & (SEQ - 1)) != 0) { const v2u w = *(const GAS v2u*)(p + (size_t)(m0 - 1) * NP + 1536 + 4 * lane); prev[0] = bflo(w.x); prev[1] = bfhi(w.x); prev[2] = bflo(w.y); prev[3] = bfhi(w.y); }
        v2u nwq[8];
#pragma unroll
        for (int u = 0; u < 8; ++u) nwq[u] = *(const GAS v2u*)(p + (size_t)(m0 + u) * NP + 1536 + 4 * lane);
        for (int r0 = 0; r0 < 32; r0 += 8) {
#pragma unroll
          for (int u = 0; u < 8; ++u) {
            const int m = m0 + r0 + u;
            const v2u w = nwq[u];
            if (r0 + 8 < 32) nwq[u] = *(const GAS v2u*)(p + (size_t)(m + 8) * NP + 1536 + 4 * lane);
            float cur[4] = {bflo(w.x), bfhi(w.x), bflo(w.y), bfhi(w.y)}, a[4];
#pragma unroll
            for (int i = 0; i < 4; ++i) { const float xs = cur[i] + mu4[i] * (prev[i] - cur[i]); prev[i] = cur[i];
                const float ex = __expf(lane < 16 ? -2.0f * xs : -xs), rc = __builtin_amdgcn_rcpf(1.0f + ex);
                a[i] = lane < 16 ? 2.0f * rc - 1.0f : (lane < 32 ? xs : rc); }
            *(GAS v2u*)(alora + (size_t)m * KLORA + 4 * lane) = (v2u){pk2(a[0], a[1]), pk2(a[2], a[3])};
          }
        }
    }
}
__device__ __forceinline__ float red8_dpp(float x) { x += DPP_F(x, 0xB1); x += DPP_F(x, 0x4E); x += DPP_F(x, 0x141); return x; }

constexpr int RW_CH = 32, RW_ARR = RW_CH * 64, RW_BUF = 6 * RW_ARR, RW_Y = 2 * RW_BUF, RW_CST = RW_Y + 2 * RW_ARR;
constexpr int RW_D = 0, RW_NK = RW_ARR, RW_KA = 2 * RW_ARR, RW_KF = 3 * RW_ARR, RW_R = 4 * RW_ARR, RW_V = 5 * RW_ARR;
struct RwOps { f32x2 d[4], nk[4], ka[4], kf[4], r[4]; f32x2 v; };
__device__ __forceinline__ void rw_load(RwOps& o, const LAS float* buf, int i, int k0, int row0) {
    const LAS float* q = buf + i * 64 + k0;
#define RW_LD(dst, off) do { const f32x4 a_ = *(const LAS f32x4*)(q + (off)), b_ = *(const LAS f32x4*)(q + (off) + 4); dst[0] = (f32x2){a_[0], a_[1]}; dst[1] = (f32x2){a_[2], a_[3]}; dst[2] = (f32x2){b_[0], b_[1]}; dst[3] = (f32x2){b_[2], b_[3]}; } while (0)
    RW_LD(o.d, RW_D); RW_LD(o.nk, RW_NK); RW_LD(o.ka, RW_KA); RW_LD(o.kf, RW_KF); RW_LD(o.r, RW_R);
#undef RW_LD
    o.v = *(const LAS f32x2*)(buf + RW_V + i * 64 + row0);
}
__device__ __forceinline__ void rw_step(f32x2 (&s0)[4], f32x2 (&s1)[4], const RwOps& o, LAS float* ybuf, int i, int row0, bool writer) {
    f32x2 a0 = s0[0] * o.nk[0], a1 = s1[0] * o.nk[0];
#pragma unroll
    for (int q = 1; q < 4; ++q) { a0 += s0[q] * o.nk[q]; a1 += s1[q] * o.nk[q]; }
    const float sa0 = red8_dpp(a0.x + a0.y), sa1 = red8_dpp(a1.x + a1.y);
    const f32x2 sa0v = {sa0, sa0}, sa1v = {sa1, sa1}, v0 = {o.v.x, o.v.x}, v1 = {o.v.y, o.v.y};
#pragma unroll
    for (int q = 0; q < 4; ++q) { s0[q] = s0[q] * o.d[q] + (sa0v * o.ka[q] + v0 * o.kf[q]); s1[q] = s1[q] * o.d[q] + (sa1v * o.ka[q] + v1 * o.kf[q]); }
    f32x2 y0 = s0[0] * o.r[0], y1 = s1[0] * o.r[0];
#pragma unroll
    for (int q = 1; q < 4; ++q) { y0 += s0[q] * o.r[q]; y1 += s1[q] * o.r[q]; }
    const float yy0 = red8_dpp(y0.x + y0.y), yy1 = red8_dpp(y1.x + y1.y);
    if (writer) *(LAS f32x2*)(ybuf + i * 64 + row0) = (f32x2){yy0, yy1};
}
struct RwRaw { v4u rw, kw, vw, rwp, kwp, vwp, lw, la; };
__device__ __forceinline__ void rw_fetch(RwRaw& x, const bf16* p, const bf16* lo, size_t m, int t, int h, int c0) {
    const bf16* pr = p + m * NP + h * 64 + c0;
    x.rw = *(const GAS v4u*)(pr); x.kw = *(const GAS v4u*)(pr + 512); x.vw = *(const GAS v4u*)(pr + 1024);
    x.rwp = (v4u){0u, 0u, 0u, 0u}; x.kwp = x.rwp; x.vwp = x.rwp;
    if (t > 0) { x.rwp = *(const GAS v4u*)(pr - NP); x.kwp = *(const GAS v4u*)(pr - NP + 512); x.vwp = *(const GAS v4u*)(pr - NP + 1024); }
    x.lw = *(const GAS v4u*)(lo + m * NLORA + h * 64 + c0); x.la = *(const GAS v4u*)(lo + m * NLORA + 512 + h * 64 + c0);
}
__device__ __forceinline__ void rw_prep(const RwRaw& x, LAS float* L, LAS float* buf, int ti, int c0) {
    float rr[8], kk[8], vv[8], dd[8], aa[8], kn[8]; float ss = 0.f;
#pragma unroll
    for (int j = 0; j < 8; ++j) {
        const int c = c0 + j;
#define BFJ(w) __uint_as_float(((j & 1) ? (w[j >> 1] & 0xffff0000u) : (w[j >> 1] << 16)))
        const float rc = BFJ(x.rw), kc = BFJ(x.kw), vc = BFJ(x.vw), rpv = BFJ(x.rwp), kpv = BFJ(x.kwp), vpv = BFJ(x.vwp), lwv = BFJ(x.lw), lav = BFJ(x.la);
#undef BFJ
        rr[j] = rc + L[RW_CST + 0 * 64 + c] * (rpv - rc); kk[j] = kc + L[RW_CST + 1 * 64 + c] * (kpv - kc); vv[j] = vc + L[RW_CST + 2 * 64 + c] * (vpv - vc);
        const float z = -(L[RW_CST + 3 * 64 + c] + lwv);
        const float w = -(fmaxf(z, 0.f) + __logf(1.0f + __expf(-fabsf(z)))) - 0.5f;
        dd[j] = __expf(-__expf(w));
        aa[j] = __builtin_amdgcn_rcpf(1.0f + __expf(-(L[RW_CST + 4 * 64 + c] + lav)));
        kn[j] = kk[j] * L[RW_CST + 5 * 64 + c]; ss += kn[j] * kn[j];
    }
    ss = sum8(ss);
    const float inv = __builtin_amdgcn_rsqf(fmaxf(ss, 1e-24f));
    float o_nk[8], o_ka[8], o_kf[8];
#pragma unroll
    for (int j = 0; j < 8; ++j) { const float kkn = kn[j] * inv; o_nk[j] = -kkn; o_ka[j] = kkn * aa[j]; o_kf[j] = kk[j] * (1.0f + (aa[j] - 1.0f) * L[RW_CST + 6 * 64 + c0 + j]); }
    LAS float* q = buf + ti * 64 + c0;
#define RW_ST(off, a) do { *(LAS f32x4*)(q + (off)) = (f32x4){a[0], a[1], a[2], a[3]}; *(LAS f32x4*)(q + (off) + 4) = (f32x4){a[4], a[5], a[6], a[7]}; } while (0)
    RW_ST(RW_D, dd); RW_ST(RW_NK, o_nk); RW_ST(RW_KA, o_ka); RW_ST(RW_KF, o_kf); RW_ST(RW_R, rr); RW_ST(RW_V, vv);
#undef RW_ST
}
__device__ __forceinline__ void rw_epi(const LAS float* L, const LAS float* buf, const LAS float* ybuf, int ti, int c0, const bf16* lo, bf16* ymix, size_t m, int h) {
    const LAS float* q = buf + ti * 64 + c0; const LAS float* qy = ybuf + ti * 64 + c0;
    float y[8], r8[8], kf8[8], v8[8];
#define RW_LD8(dst, ptr) do { const f32x4 a_ = *(const LAS f32x4*)(ptr), b_ = *(const LAS f32x4*)((ptr) + 4); dst[0] = a_[0]; dst[1] = a_[1]; dst[2] = a_[2]; dst[3] = a_[3]; dst[4] = b_[0]; dst[5] = b_[1]; dst[6] = b_[2]; dst[7] = b_[3]; } while (0)
    RW_LD8(y, qy); RW_LD8(r8, q + RW_R); RW_LD8(kf8, q + RW_KF); RW_LD8(v8, q + RW_V);
#undef RW_LD8
    const v4u gw = *(const GAS v4u*)(lo + m * NLORA + 1024 + h * 64 + c0);
    float sm = 0.f, bs = 0.f;
#pragma unroll
    for (int j = 0; j < 8; ++j) { sm += y[j]; bs += r8[j] * kf8[j] * L[RW_CST + 7 * 64 + c0 + j]; }
    sm = sum8(sm); bs = sum8(bs);
    const float mean = sm * (1.0f / 64.0f); float vs = 0.f;
#pragma unroll
    for (int j = 0; j < 8; ++j) { const float dlt = y[j] - mean; vs += dlt * dlt; }
    vs = sum8(vs);
    const float rstd = __builtin_amdgcn_rsqf(vs * (1.0f / 64.0f) + 64e-5f);
    float o[8];
#pragma unroll
    for (int j = 0; j < 8; ++j) { const float g = (j & 1) ? bfhi(gw[j >> 1]) : bflo(gw[j >> 1]);
        o[j] = ((y[j] - mean) * rstd * L[RW_CST + 8 * 64 + c0 + j] + L[RW_CST + 9 * 64 + c0 + j] + bs * v8[j]) * g; }
    *(GAS v4u*)(ymix + m * D + h * 64 + c0) = (v4u){pk2(o[0], o[1]), pk2(o[2], o[3]), pk2(o[4], o[5]), pk2(o[6], o[7])};
}
__device__ __forceinline__ void rwkv_unit(Frame& F, int bh) {
    const int b = bh >> 3, h = bh & 7, tid = F.tid, lane = F.lane;
    const bf16* p = (const bf16*)(F.ws + WS_P); const bf16* lo = (const bf16*)(F.ws + WS_LORA); bf16* ymix = (bf16*)(F.ws + WS_H);
    LAS float* L = (LAS float*)F.lds;
    __syncthreads();
    if (tid < 64) { const int c = h * 64 + tid; const float* mu = F.in[6 + F.z];
        L[RW_CST + 0 * 64 + tid] = mu[c]; L[RW_CST + 1 * 64 + tid] = mu[512 + c]; L[RW_CST + 2 * 64 + tid] = mu[1024 + c];
        L[RW_CST + 3 * 64 + tid] = F.in[7 + F.z][c]; L[RW_CST + 4 * 64 + tid] = F.in[9 + F.z][c]; L[RW_CST + 5 * 64 + tid] = F.in[12 + F.z][c]; L[RW_CST + 6 * 64 + tid] = F.in[13 + F.z][c];
        L[RW_CST + 7 * 64 + tid] = F.in[14 + F.z][c]; L[RW_CST + 8 * 64 + tid] = F.in[15 + F.z][c]; L[RW_CST + 9 * 64 + tid] = F.in[16 + F.z][c]; }
    __syncthreads();
    const bool scanner = F.wave < 4;
    const int pt = tid & 255, ti = pt >> 3, c0 = (pt & 7) * 8;
    const int rp = lane >> 3, k0 = (lane & 7) * 8, row0 = 16 * (F.wave & 3) + 2 * rp;
    const size_t mb = (size_t)b * SEQ;
    constexpr int NCH = SEQ / RW_CH;
    f32x2 s0[4], s1[4];
#pragma unroll
    for (int q = 0; q < 4; ++q) { s0[q] = (f32x2){0.f, 0.f}; s1[q] = (f32x2){0.f, 0.f}; }
    if (!scanner) { RwRaw x; rw_fetch(x, p, lo, mb + ti, ti, h, c0); rw_prep(x, L, L, ti, c0); }
    __syncthreads();
    for (int ch = 0; ch < NCH; ++ch) {
        LAS float* bufc = L + (ch & 1) * RW_BUF; LAS float* bufn = L + ((ch + 1) & 1) * RW_BUF;
        LAS float* yc = L + RW_Y + (ch & 1) * RW_ARR; LAS float* yp = L + RW_Y + ((ch + 1) & 1) * RW_ARR;
        if (scanner) {
            RwOps A, B;
            rw_load(A, bufc, 0, k0, row0);
            for (int i = 0; i < RW_CH; i += 2) {
                rw_load(B, bufc, i + 1, k0, row0);
                rw_step(s0, s1, A, yc, i, row0, (lane & 7) == 0);
                if (i + 2 < RW_CH) rw_load(A, bufc, i + 2, k0, row0);
                rw_step(s0, s1, B, yc, i + 1, row0, (lane & 7) == 0);
            }
        } else {
            RwRaw x; const int tn = (ch + 1) * RW_CH + ti;
            if (ch + 1 < NCH) rw_fetch(x, p, lo, mb + tn, tn, h, c0);
            if (ch > 0) rw_epi(L, bufn, yp, ti, c0, lo, ymix, mb + (ch - 1) * RW_CH + ti, h);
            if (ch + 1 < NCH) rw_prep(x, L, bufn, ti, c0);
        }
        __syncthreads();
    }
    if (!scanner) rw_epi(L, L + ((NCH - 1) & 1) * RW_BUF, L + RW_Y + ((NCH - 1) & 1) * RW_ARR, ti, c0, lo, ymix, mb + (NCH - 1) * RW_CH + ti, h);
    __syncthreads();
}

struct ConvItem { const float* src; unsigned char* dst; };
__device__ __forceinline__ ConvItem conv_item(Frame& F, int it) {
    constexpr int I_GU = 32 * 16 * 64; ConvItem c;
    if (it < I_GU) { const int e = it >> 10, r = it & 1023, kb = r >> 6, nb = r & 63, n0 = 32 * nb; const int n1 = n0 & 1023;
        const int orow = 256 * (n1 >> 7) + (n0 >= 1024 ? 128 : 0) + (n1 & 127);
        c.src = F.in[25 + F.z] + (size_t)e * 1024 * 2048 + (size_t)(64 * kb) * 2048 + n0; c.dst = (unsigned char*)(F.ws + WS_WGU) + (size_t)e * 2048 * 1024 + (size_t)orow * 1024 + 64 * kb; }
    else { const int q = it - I_GU, e = q >> 9, r = q & 511, kb = r >> 5, nb = r & 31;
        c.src = F.in[27 + F.z] + (size_t)e * 1024 * 1024 + (size_t)(64 * kb) * 1024 + 32 * nb; c.dst = (unsigned char*)(F.ws + WS_WD) + (size_t)e * 1024 * 1024 + (size_t)(32 * nb) * 1024 + 64 * kb; }
    return c;
}
#define CONV_LDW(it) ((it) < 32 * 16 * 64 ? 2048 : 1024)
__device__ __forceinline__ void conv_issue(const ConvItem& c, int ldw, float (&t)[32], int lane) {
    const float* s = c.src + (size_t)(lane >> 5) * ldw + (lane & 31);
#pragma unroll
    for (int i = 0; i < 32; ++i) t[i] = s[(size_t)(2 * i) * ldw];
}
__device__ __forceinline__ void conv_finish(const ConvItem& c, float (&t)[32], int lane) {
    unsigned w[8];
#pragma unroll
    for (int d = 0; d < 8; ++d) {
        auto r0 = __builtin_amdgcn_permlane32_swap(__float_as_uint(t[2 * d]), __float_as_uint(t[2 * d + 16]), false, false);
        auto r1 = __builtin_amdgcn_permlane32_swap(__float_as_uint(t[2 * d + 1]), __float_as_uint(t[2 * d + 17]), false, false);
        w[d] = pg8::pk4_fp8(__uint_as_float(r0[0]) * W_SCALE, __uint_as_float(r0[1]) * W_SCALE, __uint_as_float(r1[0]) * W_SCALE, __uint_as_float(r1[1]) * W_SCALE);
    }
    GAS v4u* o = (GAS v4u*)(c.dst + (size_t)(lane & 31) * 1024 + 32 * (lane >> 5));
    o[0] = (v4u){w[0], w[1], w[2], w[3]}; o[1] = (v4u){w[4], w[5], w[6], w[7]};
}

constexpr int RT_PITCH = 1032;
constexpr int RT_HI = 0, RT_LO = 16 * RT_PITCH * 2, RT_PART = 2 * 16 * RT_PITCH * 2, RT_HIST = RT_PART + 8 * 16 * 32 * 4;
constexpr int RW_WP = 1032, RW_WL = 32 * RW_WP * 2, RW_CA = 2 * RW_WL, RW_CB = RW_CA + 4096, RW_SC = RW_CB + 4096, RW_TE = RW_SC + NWAVES * 2048, RW_HIST = RW_TE + 128, RW_END = RW_HIST + 128;
static_assert(RW_END <= 161792 && 16 * 32 * 4 <= NWAVES * 2048, "router LDS");
__device__ __forceinline__ void p5_norm2_router_w(Frame& F, const int per) {
    typedef short bf16x8 __attribute__((ext_vector_type(8)));
    const float* g2n = F.in[22 + F.z]; const float* w_router = F.in[23 + F.z]; const float* b_router = F.in[24 + F.z];
    const float* mod = (const float*)(F.ws + WS_MOD); unsigned char* h2 = (unsigned char*)(F.ws + WS_H2);
    int* idxo = (int*)(F.ws + WS_IDX); float* gateo = (float*)(F.ws + WS_GATE);
    LAS unsigned char* L = F.lds; LAS int* hist = (LAS int*)(L + RW_HIST); LAS float* te = (LAS float*)(L + RW_TE);
    const int lane = F.lane, wave = F.wave, li = lane & 15, lg = lane >> 4;
    const int blk0 = F.vcu * per, b = (blk0 * 16) / SEQ;
    const bf16* x1b = (const bf16*)(F.ws + WS_X1);
    for (int q = F.tid; q < 256; q += NWAVES * 64) { const int col = 4 * q;
        const f32x4 g = *(const f32x4*)(g2n + col), sc = *(const f32x4*)(mod + (size_t)b * 6144 + 4096 + col);
        *(LAS f32x4*)(L + RW_CA + col * 4) = g * (sc + 1.0f); *(LAS f32x4*)(L + RW_CB + col * 4) = *(const f32x4*)(mod + (size_t)b * 6144 + 3072 + col); }
    if (F.tid < 32) hist[F.tid] = 0;
    __syncthreads();
    { const int e = F.tid & 31, part = F.tid >> 5; float tsum = 0.f;
      for (int kk = 0; kk < 64; ++kk) { const int k = 64 * part + kk; const float w = w_router[k * 32 + e];
          const float wp = w * ((const LAS float*)(L + RW_CA))[k]; tsum += w * ((const LAS float*)(L + RW_CB))[k];
          const unsigned hb = f2bf(wp);
          *(LAS unsigned short*)(L + (e * RW_WP + k) * 2) = (unsigned short)hb; *(LAS unsigned short*)(L + RW_WL + (e * RW_WP + k) * 2) = (unsigned short)f2bf(wp - __uint_as_float(hb << 16)); }
      ((LAS float*)(L + RW_SC))[part * 32 + e] = tsum; }
    __syncthreads();
    if (F.tid < 32) { float t = b_router[F.tid];
#pragma unroll
        for (int part = 0; part < 16; ++part) t += ((const LAS float*)(L + RW_SC))[part * 32 + F.tid];
        te[F.tid] = t; }
    __syncthreads();
    const float br = te[lane & 31];
    LAS float* sc_ = (LAS float*)(L + RW_SC + wave * 2048);
    const int e = lane & 31, hsh = lane & 32;
#define RW_LOAD(buf, c) do { _Pragma("unroll") for (int s_ = 0; s_ < 8; ++s_) buf[s_] = xr[4 * (8 * (c) + s_)]; } while (0)
#define RW_PASS_A(buf, c) do { _Pragma("unroll") for (int s_ = 0; s_ < 8; ++s_) { const int s = 8 * (c) + s_; \
            _Pragma("unroll") for (int j = 0; j < 4; ++j) { const float a0 = bflo(buf[s_][j]), a1 = bfhi(buf[s_][j]); ss += a0 * a0 + a1 * a1; } \
            const bf16x8 bx = __builtin_bit_cast(bf16x8, buf[s_]); \
            _Pragma("unroll") for (int jb = 0; jb < 2; ++jb) { const int wo = ((16 * jb + li) * RW_WP + 32 * s + 8 * lg) * 2; \
                acc[jb] = __builtin_amdgcn_mfma_f32_16x16x32_bf16(*(const LAS bf16x8*)(L + wo), bx, acc[jb], 0, 0, 0); \
                acc[jb] = __builtin_amdgcn_mfma_f32_16x16x32_bf16(*(const LAS bf16x8*)(L + RW_WL + wo), bx, acc[jb], 0, 0, 0); } \
            if (s_ & 1) __builtin_amdgcn_sched_barrier(0); } } while (0)
#define RW_PASS_B(buf, c) do { v2u wprev_ = {0u, 0u}; _Pragma("unroll") for (int s_ = 0; s_ < 8; ++s_) { const int s = 8 * (c) + s_; const v4u xw = buf[s_]; const int col = 32 * s + 8 * lg; \
            const f32x4 ca0 = *(const LAS f32x4*)(L + RW_CA + col * 4), ca1 = *(const LAS f32x4*)(L + RW_CA + col * 4 + 16), cb0 = *(const LAS f32x4*)(L + RW_CB + col * 4), cb1 = *(const LAS f32x4*)(L + RW_CB + col * 4 + 16); \
            float hv[8]; \
            _Pragma("unroll") for (int j = 0; j < 4; ++j) { hv[2 * j] = bflo(xw[j]) * rstd; hv[2 * j + 1] = bfhi(xw[j]) * rstd; } \
            _Pragma("unroll") for (int j = 0; j < 4; ++j) { hv[j] = (hv[j] * ca0[j] + cb0[j]) * H2_SCALE; hv[4 + j] = (hv[4 + j] * ca1[j] + cb1[j]) * H2_SCALE; } \
            const v2u wcur_ = {pg8::pk4_fp8(hv[0], hv[1], hv[2], hv[3]), pg8::pk4_fp8(hv[4], hv[5], hv[6], hv[7])}; \
            if (s_ & 1) {   \
                auto r0_ = __builtin_amdgcn_permlane16_swap(wprev_.x, wcur_.x, false, false), r1_ = __builtin_amdgcn_permlane16_swap(wprev_.y, wcur_.y, false, false); \
                *(GAS v4u*)(orow + 32 * (s - 1 + (lg & 1)) - 8 * (lg & 1)) = (v4u){r0_[0], r1_[0], r0_[1], r1_[1]}; } \
            else wprev_ = wcur_; \
            if (s_ & 1) __builtin_amdgcn_sched_barrier(0); } } while (0)
    for (int it = wave; it < per; it += NWAVES) {
        const int m0 = (blk0 + it) * 16;
        const GAS v4u* xr = (const GAS v4u*)(x1b + (size_t)(m0 + li) * D + 8 * lg);
        v4u xa[8], xb[8];
        float ss = 0.f; f32x4 acc[2] = {{0.f, 0.f, 0.f, 0.f}, {0.f, 0.f, 0.f, 0.f}};
        RW_LOAD(xa, 0); RW_LOAD(xb, 1); RW_PASS_A(xa, 0); RW_LOAD(xa, 2); RW_PASS_A(xb, 1); RW_LOAD(xb, 3); RW_PASS_A(xa, 2); RW_LOAD(xa, 0); RW_PASS_A(xb, 3);
        { auto rr = __builtin_amdgcn_permlane16_swap(__float_as_uint(ss), __float_as_uint(ss), false, false); ss = __uint_as_float(rr[0]) + __uint_as_float(rr[1]); }
        { auto rr = __builtin_amdgcn_permlane32_swap(__float_as_uint(ss), __float_as_uint(ss), false, false); ss = __uint_as_float(rr[0]) + __uint_as_float(rr[1]); }
        const float rstd = 1.0f / sqrtf(ss * (1.0f / D) + 1e-6f);
#pragma unroll
        for (int jb = 0; jb < 2; ++jb) *(LAS f32x4*)(sc_ + li * 32 + 16 * jb + 4 * lg) = acc[jb] * rstd;
        unsigned char* orow = h2 + (size_t)(m0 + li) * D + 8 * lg;
        RW_LOAD(xb, 1); RW_PASS_B(xa, 0); RW_LOAD(xa, 2); RW_PASS_B(xb, 1); RW_LOAD(xb, 3); RW_PASS_B(xa, 2); RW_PASS_B(xb, 3);
        LDS_WAIT();
#pragma unroll 2
        for (int ps = 0; ps < 8; ++ps) {
            const int row = 2 * ps + (lane >> 5); float val = sc_[row * 32 + e] + br;
            float tv[4]; int tix[4];
#pragma unroll
            for (int k = 0; k < 4; ++k) { const float mx = half_max(val);
                const unsigned long long bal = __ballot(val == mx); const int who = __ffs((int)(unsigned)(bal >> hsh)) - 1;
                tv[k] = mx; tix[k] = who; if (e == who) val = -INFINITY; }
            const float e1 = __expf(tv[1] - tv[0]), e2 = __expf(tv[2] - tv[0]), e3 = __expf(tv[3] - tv[0]); const float inv = 1.0f / (1.0f + e1 + e2 + e3);
            if (e < 4) { const int ti = e == 0 ? tix[0] : e == 1 ? tix[1] : e == 2 ? tix[2] : tix[3]; const float tg = (e == 0 ? 1.0f : e == 1 ? e1 : e == 2 ? e2 : e3) * inv;
                const size_t mr = (size_t)m0 + row; idxo[mr * 4 + e] = ti; gateo[mr * 4 + e] = tg; __hip_atomic_fetch_add(&hist[ti], 1, __ATOMIC_RELAXED, __HIP_MEMORY_SCOPE_WORKGROUP); }
        }
        LDS_WAIT();
    }
#undef RW_LOAD
#undef RW_PASS_A
#undef RW_PASS_B
    __syncthreads();
    if (F.tid < 32) { const int hv_ = hist[F.tid]; if (hv_) __hip_atomic_fetch_add(F.ctl + CW_CNT + F.tid, (unsigned)hv_, __ATOMIC_RELAXED, __HIP_MEMORY_SCOPE_AGENT); }
}
__device__ __forceinline__ void p5_norm2_router(Frame& F, const int flags) {
    typedef short bf16x8 __attribute__((ext_vector_type(8)));
    const float* g2n = F.in[22 + F.z]; const float* b_router = F.in[24 + F.z];
    const float* mod = (const float*)(F.ws + WS_MOD); unsigned char* h2 = (unsigned char*)(F.ws + WS_H2);
    const bf16* wrh = (const bf16*)(F.ws + WS_WR); const bf16* wrl = wrh + 32 * 1024;
    int* idxo = (int*)(F.ws + WS_IDX); float* gateo = (float*)(F.ws + WS_GATE);
    LAS unsigned char* L = F.lds; LAS float* part = (LAS float*)(L + RT_PART); LAS int* hist = (LAS int*)(L + RT_HIST);
    const int lane = F.lane, wave = F.wave, li = lane & 15, lg = lane >> 4;
    if (F.tid < 32) hist[F.tid] = 0;
    const int gw = F.vcu * NWAVES + wave, NGW = F.G * NWAVES;
    bf16x8 wfh[2][4], wfl[2][4];
#pragma unroll
    for (int jb = 0; jb < 2; ++jb)
#pragma unroll
        for (int s = 0; s < 4; ++s) { const size_t o = (size_t)(16 * jb + li) * 1024 + 128 * wave + 32 * s + 8 * lg; wfh[jb][s] = *(const GAS bf16x8*)(wrh + o); wfl[jb][s] = *(const GAS bf16x8*)(wrl + o); }
    const float br = b_router[lane & 31];
    const int nblk = T / 16, per = (nblk + F.G - 1) / F.G;
    __syncthreads();
    const bf16* x1b = (const bf16*)(F.ws + WS_X1);
    v2u nxa[4], nxb[4]; f32x4 cAv[4], cBv[4]; int cb_ = -1;
    if (F.vcu * per < nblk) { const GAS v2u* xr = (const GAS v2u*)(x1b + (size_t)(F.vcu * per * 16 + 2 * wave) * D) + lane;
#pragma unroll
        for (int j = 0; j < 4; ++j) { nxa[j] = xr[64 * j]; nxb[j] = xr[256 + 64 * j]; } }
    if (!(flags & 4)) for (int it = 0; it < per; ++it) {
        const int blk = F.vcu * per + it;
        if (blk < nblk) {
            const int m = blk * 16 + 2 * wave, b = m / SEQ;
            f32x4 va[4], vb[4]; float ssa = 0.f, ssb = 0.f;
#pragma unroll
            for (int j = 0; j < 4; ++j) { va[j] = (f32x4){bflo(nxa[j].x), bfhi(nxa[j].x), bflo(nxa[j].y), bfhi(nxa[j].y)}; vb[j] = (f32x4){bflo(nxb[j].x), bfhi(nxb[j].x), bflo(nxb[j].y), bfhi(nxb[j].y)}; }
            if (it + 1 < per && blk + 1 < nblk) { const GAS v2u* xr = (const GAS v2u*)(x1b + (size_t)(m + 16) * D) + lane;
#pragma unroll
                for (int j = 0; j < 4; ++j) { nxa[j] = xr[64 * j]; nxb[j] = xr[256 + 64 * j]; } }
#pragma unroll
            for (int j = 0; j < 4; ++j) { ssa += (va[j].x * va[j].x + va[j].y * va[j].y) + (va[j].z * va[j].z + va[j].w * va[j].w); ssb += (vb[j].x * vb[j].x + vb[j].y * vb[j].y) + (vb[j].z * vb[j].z + vb[j].w * vb[j].w); }
            const float rsa = 1.0f / sqrtf(wave_sum(ssa) * (1.0f / D) + 1e-6f), rsb = 1.0f / sqrtf(wave_sum(ssb) * (1.0f / D) + 1e-6f);
            GAS unsigned* o4 = (GAS unsigned*)(h2 + (size_t)m * D) + lane;
            if (b != cb_) { cb_ = b;
#pragma unroll
                for (int j = 0; j < 4; ++j) { const int col = 4 * lane + 256 * j;
                    const f32x4 g = *(const f32x4*)(g2n + col), sc = *(const f32x4*)(mod + (size_t)b * 6144 + 4096 + col); cAv[j] = g * (sc + 1.0f); cBv[j] = *(const f32x4*)(mod + (size_t)b * 6144 + 3072 + col); } }
#pragma unroll
            for (int j = 0; j < 4; ++j) { const int col = 4 * lane + 256 * j;
                va[j] = va[j] * rsa * cAv[j] + cBv[j]; vb[j] = vb[j] * rsb * cAv[j] + cBv[j];
                o4[64 * j] = pg8::pk4_fp8(va[j].x * H2_SCALE, va[j].y * H2_SCALE, va[j].z * H2_SCALE, va[j].w * H2_SCALE);
                o4[256 + 64 * j] = pg8::pk4_fp8(vb[j].x * H2_SCALE, vb[j].y * H2_SCALE, vb[j].z * H2_SCALE, vb[j].w * H2_SCALE);
#define RT_SPLIT(v_, row_) do { const unsigned p0_ = attn_body::cvtpk_s((v_).x, (v_).y), p1_ = attn_body::cvtpk_s((v_).z, (v_).w);     \
                    *(LAS v2u*)(L + RT_HI + ((row_) * RT_PITCH + col) * 2) = (v2u){p0_, p1_}; \
                    *(LAS v2u*)(L + RT_LO + ((row_) * RT_PITCH + col) * 2) = (v2u){attn_body::cvtpk_s((v_).x - bflo(p0_), (v_).y - bfhi(p0_)), attn_body::cvtpk_s((v_).z - bflo(p1_), (v_).w - bfhi(p1_))}; } while (0)
                RT_SPLIT(va[j], 2 * wave); RT_SPLIT(vb[j], 2 * wave + 1);
#undef RT_SPLIT
            }
        }
        LDS_BARRIER();
        {
            f32x4 acc[2] = {{0.f, 0.f, 0.f, 0.f}, {0.f, 0.f, 0.f, 0.f}};
#pragma unroll
            for (int s = 0; s < 4; ++s) {
                const int eo = (li * RT_PITCH + 128 * wave + 32 * s + 8 * lg) * 2;
                const bf16x8 bh = *(const LAS bf16x8*)(L + RT_HI + eo), bl = *(const LAS bf16x8*)(L + RT_LO + eo);
#pragma unroll
                for (int jb = 0; jb < 2; ++jb) {
                    acc[jb] = __builtin_amdgcn_mfma_f32_16x16x32_bf16(wfh[jb][s], bh, acc[jb], 0, 0, 0);
                    acc[jb] = __builtin_amdgcn_mfma_f32_16x16x32_bf16(wfh[jb][s], bl, acc[jb], 0, 0, 0);
                    acc[jb] = __builtin_amdgcn_mfma_f32_16x16x32_bf16(wfl[jb][s], bh, acc[jb], 0, 0, 0);
                }
            }
#pragma unroll
            for (int jb = 0; jb < 2; ++jb) *(LAS f32x4*)(part + (wave * 16 + li) * 32 + 16 * jb + 4 * lg) = acc[jb];
        }
        LDS_BARRIER();
        if (blk < nblk) {
            const int row = 2 * wave + (lane >> 5), e = lane & 31; float val = br;
#pragma unroll
            for (int w = 0; w < 8; ++w) val += part[(w * 16 + row) * 32 + e];
            float tv[4]; int tix[4]; const int hsh = lane & 32;
#pragma unroll
            for (int k = 0; k < 4; ++k) { const float mx = half_max(val);
                const unsigned long long bal = __ballot(val == mx); const int who = __ffs((int)(unsigned)(bal >> hsh)) - 1;
                tv[k] = mx; tix[k] = who; if (e == who) val = -INFINITY; }
            const float e1 = __expf(tv[1] - tv[0]), e2 = __expf(tv[2] - tv[0]), e3 = __expf(tv[3] - tv[0]); const float inv = 1.0f / (1.0f + e1 + e2 + e3);
            if (e < 4) { const int ti = e == 0 ? tix[0] : e == 1 ? tix[1] : e == 2 ? tix[2] : tix[3]; const float tg = (e == 0 ? 1.0f : e == 1 ? e1 : e == 2 ? e2 : e3) * inv;
                const size_t mr = (size_t)blk * 16 + row; idxo[mr * 4 + e] = ti; gateo[mr * 4 + e] = tg; __hip_atomic_fetch_add(&hist[ti], 1, __ATOMIC_RELAXED, __HIP_MEMORY_SCOPE_WORKGROUP); }
        }
        LDS_BARRIER();
    }
    __syncthreads();
    if (F.tid < 32) { const int hv = hist[F.tid]; if (hv) __hip_atomic_fetch_add(F.ctl + CW_CNT + F.tid, (unsigned)hv, __ATOMIC_RELAXED, __HIP_MEMORY_SCOPE_AGENT); }
}

__device__ __forceinline__ void p6_positions(Frame& F) {
    const int* idxo = (const int*)(F.ws + WS_IDX); int* pos_of = (int*)(F.ws + WS_POS); int* stok = (int*)(F.ws + WS_STOK);
    LAS int* lcount = (LAS int*)F.lds; LAS int* gbase = lcount + 32; LAS int* pstart = lcount + 64;
    for (int tg = F.vcu; tg < T / 256; tg += F.G) {
        if (F.tid < 32) lcount[F.tid] = 0;
        if (F.wave == 0) { int cnt = F.lane < 32 ? (int)F.ctl[CW_CNT + F.lane] : 0; const int padded = (cnt + 255) & ~255; int incl = padded;
#pragma unroll
            for (int o = 1; o < 32; o <<= 1) { const int t = __shfl_up(incl, o); if (F.lane >= o) incl += t; }
            if (F.lane < 32) pstart[F.lane] = incl - padded; }
        __syncthreads();
        int e[2], lr[2];
#pragma unroll
        for (int j = 0; j < 2; ++j) { const int s = F.tid * 2 + j; e[j] = idxo[(size_t)tg * 1024 + s]; lr[j] = __hip_atomic_fetch_add(&lcount[e[j]], 1, __ATOMIC_RELAXED, __HIP_MEMORY_SCOPE_WORKGROUP); }
        __syncthreads();
        if (F.tid < 32) gbase[F.tid] = (int)__hip_atomic_fetch_add(F.ctl + CW_CUR + F.tid, (unsigned)lcount[F.tid], __ATOMIC_RELAXED, __HIP_MEMORY_SCOPE_AGENT);
        __syncthreads();
#pragma unroll
        for (int j = 0; j < 2; ++j) { const int s = F.tid * 2 + j; const int pos = pstart[e[j]] + gbase[e[j]] + lr[j]; stok[pos] = tg * 256 + (s >> 2); pos_of[(size_t)tg * 1024 + s] = pos; }
        __syncthreads();
    }
}

__device__ __forceinline__ int moe_tables(Frame& F) {
    LAS unsigned char* blk2e = (LAS unsigned char*)(F.lds + BLK2E_OFF); LAS unsigned short* blkvalid = (LAS unsigned short*)(F.lds + BLKVALID_OFF);
    __syncthreads();
    if (F.wave == 0) { const int cnt = F.lane < 32 ? (int)F.ctl[CW_CNT + F.lane] : 0; const int nb = (cnt + 255) >> 8; int incl = nb;
#pragma unroll
        for (int o = 1; o < 32; o <<= 1) { const int t = __shfl_up(incl, o); if (F.lane >= o) incl += t; }
        const int st = incl - nb;
        for (int j = 0; j < nb; ++j) { blk2e[st + j] = (unsigned char)F.lane; const int rem = cnt - 256 * j; blkvalid[st + j] = (unsigned short)(rem < 256 ? rem : 256); }
        if (F.lane == 31) F.MISC[16] = (unsigned)incl; }
    __syncthreads();
    return (int)F.MISC[16];
}

__device__ __forceinline__ void p9_combine(Frame& F) {
    const float* mod = (const float*)(F.ws + WS_MOD); const float* fg = F.in[29 + F.z];
    const int* pos_of = (const int*)(F.ws + WS_POS); const float* gateo = (const float*)(F.ws + WS_GATE); const unsigned char* ys = (const unsigned char*)(F.ws + WS_YS);
    const int gw = F.vcu * NWAVES + F.wave, NGW = F.G * NWAVES, lane = F.lane;
    typedef int i32x4v __attribute__((ext_vector_type(4)));
    const bf16* x1b = (const bf16*)(F.ws + WS_X1);
    struct RowBuf { v2u x[4]; unsigned y[4][4]; };
#define P9_ISSUE(buf, mrow, ps) do { const GAS v2u* xr_ = (const GAS v2u*)(x1b + (size_t)(mrow) * D) + lane; \
        _Pragma("unroll") for (int j = 0; j < 4; ++j) (buf).x[j] = xr_[64 * j]; \
        _Pragma("unroll") for (int k = 0; k < 4; ++k) { const GAS unsigned* yr_ = (const GAS unsigned*)(ys + (size_t)(ps)[k] * D) + lane; \
            _Pragma("unroll") for (int j = 0; j < 4; ++j) (buf).y[k][j] = yr_[64 * j]; } } while (0)
    for (int rg = gw; rg < T / 32; rg += NGW) {
        const int m0 = rg * 32, b = m0 / SEQ;
        f32x4 g2v[4], fgv[4];
#pragma unroll
        for (int j = 0; j < 4; ++j) { const int col = 4 * lane + 256 * j; g2v[j] = *(const f32x4*)(mod + (size_t)b * 6144 + 5120 + col); fgv[j] = *(const f32x4*)(fg + col); }
        i32x4v ps1 = *(const GAS i32x4v*)(pos_of + (size_t)m0 * 4), ps2 = *(const GAS i32x4v*)(pos_of + (size_t)(m0 + 1) * 4);
        f32x4 gt0, gt1 = *(const GAS f32x4*)(gateo + (size_t)m0 * 4), gt2 = *(const GAS f32x4*)(gateo + (size_t)(m0 + 1) * 4);
        RowBuf nb; P9_ISSUE(nb, m0, ps1);
        for (int r = 0; r < 32; ++r) {
            const int m = m0 + r;
            const RowBuf cb = nb; gt0 = gt1;
            if (r + 1 < 32) { P9_ISSUE(nb, m + 1, ps2); gt1 = gt2; }
            if (r + 2 < 32) { ps2 = *(const GAS i32x4v*)(pos_of + (size_t)(m + 2) * 4); gt2 = *(const GAS f32x4*)(gateo + (size_t)(m + 2) * 4); }
            f32x4 acc[4];
#pragma unroll
            for (int j = 0; j < 4; ++j) acc[j] = (f32x4){0.f, 0.f, 0.f, 0.f};
#pragma unroll
            for (int k = 0; k < 4; ++k)
#pragma unroll
                for (int j = 0; j < 4; ++j) { const unsigned w = cb.y[k][j]; const f32x2 lo2 = __builtin_amdgcn_cvt_pk_f32_fp8((int)w, false), hi2 = __builtin_amdgcn_cvt_pk_f32_fp8((int)w, true); acc[j] += (f32x4){lo2.x, lo2.y, hi2.x, hi2.y} * (gt0[k] * (1.0f / YS_SCALE)); }
            f32x4 z[4]; float ss = 0.f;
#pragma unroll
            for (int j = 0; j < 4; ++j) { z[j] = (f32x4){bflo(cb.x[j].x), bfhi(cb.x[j].x), bflo(cb.x[j].y), bfhi(cb.x[j].y)} + g2v[j] * acc[j]; ss += (z[j].x * z[j].x + z[j].y * z[j].y) + (z[j].z * z[j].z + z[j].w * z[j].w); }
            const float rstd = 1.0f / sqrtf(wave_sum(ss) * (1.0f / D) + 1e-6f);
#ifdef RWC_CMP
            { const float e2 = ((const float*)F.ctl)[600], r2 = ((const float*)F.ctl)[601]; const float sc = 1.0f + sqrtf(e2 / fmaxf(r2, 1e-30f));
#pragma unroll
              for (int j = 0; j < 4; ++j) z[j] = z[j] * sc; }
#endif
            GAS f32x4* xo = (GAS f32x4*)(F.out + (size_t)m * D) + lane;
#pragma unroll
            for (int j = 0; j < 4; ++j) xo[64 * j] = z[j] * rstd * fgv[j];
        }
    }
#undef P9_ISSUE
}
namespace rwc {
typedef short bf16x8 __attribute__((ext_vector_type(8)));
typedef short s16x4 __attribute__((ext_vector_type(4)));
constexpr int PITCH = 72, MATB = 64 * PITCH * 2;
enum { B_PA = 0, B_AB, B_VT, B_BT, B_KT, B_M1, B_LD, B_RB, B_P1, B_P2, B_XA, B_WO, B_S0, B_S1, B_GT, NBUF };
constexpr int B_EH = B_AB, B_EL = B_M1;
constexpr int OFF_CUM = NBUF * MATB, OFF_GEND = OFF_CUM + 64 * 64 * 4, OFF_BONUS = OFF_GEND + 256, OFF_CST = OFF_BONUS + 512, RWC_BYTES = OFF_CST + 10 * 64 * 4;
static_assert(RWC_BYTES <= 161792, "chunked RWKV LDS");
typedef const LAS unsigned char* lcp;
__device__ __forceinline__ bf16x8 frag_rm(lcp img, int rb, int s, int lane) { return *(const LAS bf16x8*)(img + ((16 * rb + (lane & 15)) * PITCH + 32 * s + 8 * (lane >> 4)) * 2); }
__device__ __forceinline__ bf16x8 frag_tr(lcp img, int cb, int s, int lane) {
#ifdef RWC_SLOW_TR
    bf16x8 o_;
#pragma unroll
    for (int jj = 0; jj < 8; ++jj) o_[jj] = *(const LAS short*)(img + ((32 * s + 8 * (lane >> 4) + jj) * PITCH + 16 * cb + (lane & 15)) * 2);
    return o_;
#endif
    const int q = (lane & 15) >> 2, p = lane & 3; lcp a = img + ((32 * s + 8 * (lane >> 4) + q) * PITCH + 16 * cb + 4 * p) * 2;
    const s16x4 lo = __builtin_bit_cast(s16x4, __builtin_amdgcn_ds_read_tr16_b64_v4i16((LAS attn_body::v4i16_t*)a));
    const s16x4 hi = __builtin_bit_cast(s16x4, __builtin_amdgcn_ds_read_tr16_b64_v4i16((LAS attn_body::v4i16_t*)(a + 4 * PITCH * 2)));
    return (bf16x8){lo[0], lo[1], lo[2], lo[3], hi[0], hi[1], hi[2], hi[3]};
}
#define RWC_MMA(acc, afrag, bfrag) acc = __builtin_amdgcn_mfma_f32_16x16x32_bf16(afrag, bfrag, acc, 0, 0, 0)
__device__ __forceinline__ void store_tile(LAS unsigned char* img, int ib, int jb, int lane, const f32x4& a) {
    *(LAS v2u*)(img + ((16 * ib + (lane & 15)) * PITCH + 16 * jb + 4 * (lane >> 4)) * 2) = (v2u){attn_body::cvtpk_s(a[0], a[1]), attn_body::cvtpk_s(a[2], a[3])};
}
}

struct RwcRaw { v4u rw, kw, vw, rwp, kwp, vwp, lw, la; };
__device__ __forceinline__ void rwc_fetch(RwcRaw& x, const bf16* p, const bf16* lo, size_t m, int t, int h, int c0) {
    const bf16* pr = p + m * NP + h * 64 + c0;
    x.rw = *(const GAS v4u*)(pr); x.kw = *(const GAS v4u*)(pr + 512); x.vw = *(const GAS v4u*)(pr + 1024);
    x.rwp = (v4u){0u, 0u, 0u, 0u}; x.kwp = x.rwp; x.vwp = x.rwp;
    if (t > 0) { x.rwp = *(const GAS v4u*)(pr - NP); x.kwp = *(const GAS v4u*)(pr - NP + 512); x.vwp = *(const GAS v4u*)(pr - NP + 1024); }
    x.lw = *(const GAS v4u*)(lo + m * NLORA + h * 64 + c0); x.la = *(const GAS v4u*)(lo + m * NLORA + 512 + h * 64 + c0);
}
#ifdef RWC_DBLBAR
#define RWC_BAR() do { LDS_BARRIER(); LDS_BARRIER(); } while (0)
#else
#define RWC_BAR() LDS_BARRIER()
#endif
__device__ __forceinline__ void rwkv_unit_chunked(Frame& F, int bh, bf16* yout, int ypitch, const int dflags = 0) {
    using namespace rwc;
    const int b = bh >> 3, h = bh & 7, tid = F.tid, lane = F.lane, wave = F.wave;
    const bf16* p = (const bf16*)(F.ws + WS_P); const bf16* lo = (const bf16*)(F.ws + WS_LORA);
    LAS unsigned char* L = F.lds;
#define IMG(i) (L + (i) * MATB)
    LAS float* cum = (LAS float*)(L + OFF_CUM); LAS float* gend = (LAS float*)(L + OFF_GEND); LAS float* bonus = (LAS float*)(L + OFF_BONUS); LAS float* cst = (LAS float*)(L + OFF_CST);
    __syncthreads();
    if (tid < 64) { const int c = h * 64 + tid; const float* mu = F.in[6 + F.z];
        cst[0 * 64 + tid] = mu[c]; cst[1 * 64 + tid] = mu[512 + c]; cst[2 * 64 + tid] = mu[1024 + c];
        cst[3 * 64 + tid] = F.in[7 + F.z][c]; cst[4 * 64 + tid] = F.in[9 + F.z][c]; cst[5 * 64 + tid] = F.in[12 + F.z][c]; cst[6 * 64 + tid] = F.in[13 + F.z][c];
        cst[7 * 64 + tid] = F.in[14 + F.z][c]; cst[8 * 64 + tid] = F.in[15 + F.z][c]; cst[9 * 64 + tid] = F.in[16 + F.z][c]; }
    const int tib[2] = {(2 * wave) >> 2, (2 * wave + 1) >> 2}, tjb[2] = {(2 * wave) & 3, (2 * wave + 1) & 3};
    const int li = lane & 15, lg = lane >> 4;
    bf16x8 ltf[2];
#pragma unroll
    for (int s = 0; s < 2; ++s)
#pragma unroll
        for (int j = 0; j < 8; ++j) ltf[s][j] = (32 * s + 8 * lg + j <= 16 * (wave & 3) + li) ? (short)0x3f80 : (short)0;
    f32x4 accS[2];
#pragma unroll
    for (int u = 0; u < 2; ++u) accS[u] = (f32x4){0.f, 0.f, 0.f, 0.f};
    for (int e = tid; e < MATB / 4; e += NWAVES * 64) { ((LAS unsigned*)IMG(B_S0))[e] = 0u; ((LAS unsigned*)IMG(B_LD))[e] = 0u; ((LAS unsigned*)IMG(B_WO))[e] = 0u; }
    const size_t mb = (size_t)b * SEQ;
    const int et = tid >> 3, ec0 = (tid & 7) * 8;
    constexpr int NCH = SEQ / 64;
    RwcRaw nx;
    rwc_fetch(nx, p, lo, mb + et, et, h, ec0);
    __syncthreads();
    float o_al[8], o_be[8], o_kf[8], o_r[8], o_v[8], o_ew[8];
    v4u gw = {0u, 0u, 0u, 0u};
    { const int cp = 0; const RwcRaw x = nx;
      rwc_fetch(nx, p, lo, mb + 64 + et, 64 + et, h, ec0);
      gw = *(const GAS v4u*)(lo + (mb + et) * NLORA + 1024 + h * 64 + ec0);
#pragma unroll
        for (int j = 0; j < 8; ++j) { o_al[j] = 0.f; o_be[j] = 0.f; o_kf[j] = 0.f; o_r[j] = 0.f; o_v[j] = 0.f; o_ew[j] = 0.f; }
        {
            float kn[8], aa[8]; float ss = 0.f, bq = 0.f;
#pragma unroll
            for (int j = 0; j < 8; ++j) {
                const int c = ec0 + j;
#define BFJ(w) __uint_as_float(((j & 1) ? (w[j >> 1] & 0xffff0000u) : (w[j >> 1] << 16)))
                const float rc = BFJ(x.rw), kc = BFJ(x.kw), vc = BFJ(x.vw), rp = BFJ(x.rwp), kp = BFJ(x.kwp), vp = BFJ(x.vwp), lwv = BFJ(x.lw), lav = BFJ(x.la);
#undef BFJ
                o_r[j] = rc + cst[0 * 64 + c] * (rp - rc); const float kk = kc + cst[1 * 64 + c] * (kp - kc); o_v[j] = vc + cst[2 * 64 + c] * (vp - vc);
                o_ew[j] = 0.6065306597f * __builtin_amdgcn_rcpf(1.0f + __expf(-(cst[3 * 64 + c] + lwv)));
                aa[j] = __builtin_amdgcn_rcpf(1.0f + __expf(-(cst[4 * 64 + c] + lav)));
                kn[j] = kk * cst[5 * 64 + c]; ss += kn[j] * kn[j];
                o_kf[j] = kk * (1.0f + (aa[j] - 1.0f) * cst[6 * 64 + c]);
                bq += o_r[j] * o_kf[j] * cst[7 * 64 + c];
            }
            ss = sum8(ss); bq = sum8(bq);
            const float inv = __builtin_amdgcn_rsqf(fmaxf(ss, 1e-24f));
            if ((tid & 7) == 0) bonus[(cp & 1) * 64 + et] = bq;
            unsigned eh[4], el[4];
#pragma unroll
            for (int j = 0; j < 8; ++j) { const float kkn = kn[j] * inv; o_al[j] = -kkn; o_be[j] = kkn * aa[j]; }
#pragma unroll
            for (int j = 0; j < 4; ++j) { const unsigned hi0 = f2bf(o_ew[2 * j]), hi1 = f2bf(o_ew[2 * j + 1]);
                eh[j] = hi0 | (hi1 << 16); el[j] = pk2(o_ew[2 * j] - __uint_as_float(hi0 << 16), o_ew[2 * j + 1] - __uint_as_float(hi1 << 16)); }
            *(LAS v4u*)(IMG(B_EH) + (et * PITCH + ec0) * 2) = (v4u){eh[0], eh[1], eh[2], eh[3]};
            *(LAS v4u*)(IMG(B_EL) + (et * PITCH + ec0) * 2) = (v4u){el[0], el[1], el[2], el[3]};
        }
    }
        RWC_BAR();
        if (wave >= 4) {
            const int ib = wave - 4;
#pragma unroll
            for (int jb = 0; jb < 4; ++jb) {
                f32x4 aC = {0.f, 0.f, 0.f, 0.f};
#pragma unroll
                for (int s = 0; s < 2; ++s) { RWC_MMA(aC, frag_tr(IMG(B_EH), jb, s, lane), ltf[s]); RWC_MMA(aC, frag_tr(IMG(B_EL), jb, s, lane), ltf[s]); }
                *(LAS f32x4*)(cum + (16 * ib + li) * 64 + 16 * jb + 4 * lg) = aC;
            }
        }
        RWC_BAR();
         {
            const f32x4 c0v = *(const LAS f32x4*)(cum + et * 64 + ec0), c1v = *(const LAS f32x4*)(cum + et * 64 + ec0 + 4);
            unsigned wab[4], wbt[4], wkt[4], wrb[4], wvt[4]; float gi8[8];
#pragma unroll
            for (int j = 0; j < 8; j += 2) {
                float va[2], vb[2], vk[2], vr[2];
#pragma unroll
                for (int q = 0; q < 2; ++q) { const float ci = (j + q) < 4 ? c0v[(j + q) & 3] : c1v[(j + q) & 3];
                    const float gi = __expf(-ci), ginv = __expf(ci), ge = __expf(o_ew[j + q] - ci);
                    gi8[j + q] = gi; va[q] = o_al[j + q] * ge; vb[q] = o_be[j + q] * ginv; vk[q] = o_kf[j + q] * ginv; vr[q] = o_r[j + q] * gi; }
                wab[j >> 1] = attn_body::cvtpk_s(va[0], va[1]); wbt[j >> 1] = attn_body::cvtpk_s(vb[0], vb[1]); wkt[j >> 1] = attn_body::cvtpk_s(vk[0], vk[1]);
                wrb[j >> 1] = attn_body::cvtpk_s(vr[0], vr[1]); wvt[j >> 1] = attn_body::cvtpk_s(o_v[j], o_v[j + 1]);
            }
            const int eo = (et * PITCH + ec0) * 2;
            *(LAS v4u*)(IMG(B_AB) + eo) = (v4u){wab[0], wab[1], wab[2], wab[3]}; *(LAS v4u*)(IMG(B_BT) + eo) = (v4u){wbt[0], wbt[1], wbt[2], wbt[3]};
            *(LAS v4u*)(IMG(B_KT) + eo) = (v4u){wkt[0], wkt[1], wkt[2], wkt[3]}; *(LAS v4u*)(IMG(B_RB) + eo) = (v4u){wrb[0], wrb[1], wrb[2], wrb[3]};
            *(LAS v4u*)(IMG(B_VT) + eo) = (v4u){wvt[0], wvt[1], wvt[2], wvt[3]};
            if (et == 63) { *(LAS f32x4*)(gend + ec0) = (f32x4){gi8[0], gi8[1], gi8[2], gi8[3]}; *(LAS f32x4*)(gend + ec0 + 4) = (f32x4){gi8[4], gi8[5], gi8[6], gi8[7]}; }
        }
        RWC_BAR();
    for (int ch = 0; ch < NCH; ++ch) {
        LAS unsigned char* s_cur = IMG(B_S0 + (ch & 1)); LAS unsigned char* s_nxt = IMG(B_S0 + ((ch + 1) & 1));
        const bool more = ch + 1 < NCH; v4u gwn = gw;
        {
            const int ib = tib[0];
            f32x4 aN[2], aM[2], aP1[2], aP2[2];
#pragma unroll
            for (int u = 0; u < 2; ++u) { aN[u] = (f32x4){0.f, 0.f, 0.f, 0.f}; aM[u] = aN[u]; aP1[u] = aN[u]; aP2[u] = aN[u]; }
#pragma unroll
            for (int s = 0; s < 2; ++s) {
                const bf16x8 fab = frag_rm(IMG(B_AB), ib, s, lane), frb = frag_rm(IMG(B_RB), ib, s, lane);
#pragma unroll
                for (int u = 0; u < 2; ++u) { const bf16x8 fbt = frag_rm(IMG(B_BT), tjb[u], s, lane), fkt = frag_rm(IMG(B_KT), tjb[u], s, lane);
                    RWC_MMA(aN[u], fbt, fab); RWC_MMA(aM[u], fkt, fab); RWC_MMA(aP1[u], fbt, frb); RWC_MMA(aP2[u], fkt, frb); }
            }
            const int ti_ = 16 * ib + li;
#pragma unroll
            for (int u = 0; u < 2; ++u) { const int jb = tjb[u];
#pragma unroll
                for (int r = 0; r < 4; ++r) { const int j = 16 * jb + 4 * lg + r;
                    if (!(j < ti_)) { aN[u][r] = 0.f; aM[u][r] = 0.f; } if (!(j <= ti_)) { aP1[u][r] = 0.f; aP2[u][r] = 0.f; } }
                store_tile(IMG(B_PA), ib, jb, lane, aN[u]); store_tile(IMG(B_M1), ib, jb, lane, aM[u]);
                store_tile(IMG(B_P1), ib, jb, lane, aP1[u]); store_tile(IMG(B_P2), ib, jb, lane, aP2[u]); }
        }
        RWC_BAR();
        if (wave == 0) {
            const int bb = lane >> 4, jc = lane & 15; float Lc[16];
            lcp nb = IMG(B_PA) + ((16 * bb) * PITCH + 16 * bb) * 2;
#pragma unroll
            for (int t = 0; t < 16; ++t) {
                float a0 = (t == jc) ? 1.0f : 0.0f, a1 = 0.f;
                v4u r0 = {0u, 0u, 0u, 0u}, r1 = {0u, 0u, 0u, 0u};
                if (t > 0) r0 = *(const LAS v4u*)(nb + t * PITCH * 2);
                if (t > 8) r1 = *(const LAS v4u*)(nb + t * PITCH * 2 + 16);
#pragma unroll
                for (int m = 0; m < 16; ++m) if (m < t - 1) { const unsigned w = m < 8 ? r0[m >> 1] : r1[(m - 8) >> 1]; const float nv = (m & 1) ? bfhi(w) : bflo(w);
                    if (m & 1) a1 += nv * Lc[m]; else a0 += nv * Lc[m]; }
                float lt = a0 + a1;
                if (t > 0) { const int m = t - 1; const unsigned w = m < 8 ? r0[m >> 1] : r1[(m - 8) >> 1]; lt += ((m & 1) ? bfhi(w) : bflo(w)) * Lc[m]; }
                Lc[t] = lt;
            }
#pragma unroll
            for (int t = 0; t < 16; ++t) *(LAS unsigned short*)(IMG(B_LD) + ((16 * bb + t) * PITCH + 16 * bb + jc) * 2) = (unsigned short)f2bf(Lc[t]);
        }
        else if (wave >= 4) {
            const int ib = wave - 4;
            f32x4 aG[4] = {{0.f, 0.f, 0.f, 0.f}, {0.f, 0.f, 0.f, 0.f}, {0.f, 0.f, 0.f, 0.f}, {0.f, 0.f, 0.f, 0.f}};
#pragma unroll
            for (int s = 0; s < 2; ++s) { const bf16x8 fs = frag_rm(s_cur, ib, s, lane), fv = frag_tr(IMG(B_VT), ib, s, lane);
#pragma unroll
                for (int jb = 0; jb < 4; ++jb) { RWC_MMA(aG[jb], frag_rm(IMG(B_AB), jb, s, lane), fs); RWC_MMA(aG[jb], frag_rm(IMG(B_M1), jb, s, lane), fv); } }
#pragma unroll
            for (int jb = 0; jb < 4; ++jb) store_tile(IMG(B_GT), ib, jb, lane, aG[jb]);
        }
        RWC_BAR();
        if (wave < 6) {
            const int b = wave == 0 ? 1 : (wave < 3 ? 2 : 3), bp = wave == 0 ? 0 : (wave < 3 ? wave - 1 : wave - 3), s = b >> 1;
            f32x4 aW = {0.f, 0.f, 0.f, 0.f};
            RWC_MMA(aW, frag_tr(IMG(B_PA), bp, s, lane), frag_rm(IMG(B_LD), b, s, lane));
            store_tile(IMG(B_WO), b, bp, lane, aW);
        }
        if (more) { const int cp = ch + 1; const RwcRaw x = nx;
            if (ch + 2 < NCH) rwc_fetch(nx, p, lo, mb + (size_t)(ch + 2) * 64 + et, (ch + 2) * 64 + et, h, ec0);
            gwn = *(const GAS v4u*)(lo + (mb + (size_t)(ch + 1) * 64 + et) * NLORA + 1024 + h * 64 + ec0);
#pragma unroll
        for (int j = 0; j < 8; ++j) { o_al[j] = 0.f; o_be[j] = 0.f; o_kf[j] = 0.f; o_r[j] = 0.f; o_v[j] = 0.f; o_ew[j] = 0.f; }
        {
            float kn[8], aa[8]; float ss = 0.f, bq = 0.f;
#pragma unroll
            for (int j = 0; j < 8; ++j) {
                const int c = ec0 + j;
#define BFJ(w) __uint_as_float(((j & 1) ? (w[j >> 1] & 0xffff0000u) : (w[j >> 1] << 16)))
                const float rc = BFJ(x.rw), kc = BFJ(x.kw), vc = BFJ(x.vw), rp = BFJ(x.rwp), kp = BFJ(x.kwp), vp = BFJ(x.vwp), lwv = BFJ(x.lw), lav = BFJ(x.la);
#undef BFJ
                o_r[j] = rc + cst[0 * 64 + c] * (rp - rc); const float kk = kc + cst[1 * 64 + c] * (kp - kc); o_v[j] = vc + cst[2 * 64 + c] * (vp - vc);
                o_ew[j] = 0.6065306597f * __builtin_amdgcn_rcpf(1.0f + __expf(-(cst[3 * 64 + c] + lwv)));
                aa[j] = __builtin_amdgcn_rcpf(1.0f + __expf(-(cst[4 * 64 + c] + lav)));
                kn[j] = kk * cst[5 * 64 + c]; ss += kn[j] * kn[j];
                o_kf[j] = kk * (1.0f + (aa[j] - 1.0f) * cst[6 * 64 + c]);
                bq += o_r[j] * o_kf[j] * cst[7 * 64 + c];
            }
            ss = sum8(ss); bq = sum8(bq);
            const float inv = __builtin_amdgcn_rsqf(fmaxf(ss, 1e-24f));
            if ((tid & 7) == 0) bonus[(cp & 1) * 64 + et] = bq;
            unsigned eh[4], el[4];
#pragma unroll
            for (int j = 0; j < 8; ++j) { const float kkn = kn[j] * inv; o_al[j] = -kkn; o_be[j] = kkn * aa[j]; }
#pragma unroll
            for (int j = 0; j < 4; ++j) { const unsigned hi0 = f2bf(o_ew[2 * j]), hi1 = f2bf(o_ew[2 * j + 1]);
                eh[j] = hi0 | (hi1 << 16); el[j] = pk2(o_ew[2 * j] - __uint_as_float(hi0 << 16), o_ew[2 * j + 1] - __uint_as_float(hi1 << 16)); }
            *(LAS v4u*)(IMG(B_EH) + (et * PITCH + ec0) * 2) = (v4u){eh[0], eh[1], eh[2], eh[3]};
            *(LAS v4u*)(IMG(B_EL) + (et * PITCH + ec0) * 2) = (v4u){el[0], el[1], el[2], el[3]};
        }
        }
        RWC_BAR();
        if (wave < 4) {
#pragma unroll
            for (int b = 0; b < 4; ++b) {
                f32x4 aU = {0.f, 0.f, 0.f, 0.f};
#pragma unroll
                for (int s = 0; s < 2; ++s) { const bf16x8 fh = frag_rm(IMG(B_GT), wave, s, lane);
                    RWC_MMA(aU, frag_rm(IMG(B_LD), b, s, lane), fh); RWC_MMA(aU, frag_rm(IMG(B_WO), b, s, lane), fh); }
                store_tile(IMG(B_GT), wave, b, lane, aU);
            }
        }
        if (more) {
        if (wave >= 4) {
            const int ib = wave - 4;
#pragma unroll
            for (int jb = 0; jb < 4; ++jb) {
                f32x4 aC = {0.f, 0.f, 0.f, 0.f};
#pragma unroll
                for (int s = 0; s < 2; ++s) { RWC_MMA(aC, frag_tr(IMG(B_EH), jb, s, lane), ltf[s]); RWC_MMA(aC, frag_tr(IMG(B_EL), jb, s, lane), ltf[s]); }
                *(LAS f32x4*)(cum + (16 * ib + li) * 64 + 16 * jb + 4 * lg) = aC;
            }
        }
        }
        RWC_BAR();
        {
            const int ib = tib[0];
            f32x4 aY[2] = {{0.f, 0.f, 0.f, 0.f}, {0.f, 0.f, 0.f, 0.f}};
#pragma unroll
            for (int s = 0; s < 2; ++s) {
                const bf16x8 frb = frag_rm(IMG(B_RB), ib, s, lane), fp1 = frag_rm(IMG(B_P1), ib, s, lane), fp2 = frag_rm(IMG(B_P2), ib, s, lane), fgi = frag_rm(IMG(B_GT), ib, s, lane), fvi = frag_tr(IMG(B_VT), ib, s, lane);
#pragma unroll
                for (int u = 0; u < 2; ++u) { const int jb = tjb[u];
                    const bf16x8 fvm_j = frag_tr(IMG(B_VT), jb, s, lane);
                    RWC_MMA(aY[u], frag_rm(s_cur, jb, s, lane), frb);
                    RWC_MMA(aY[u], frag_rm(IMG(B_GT), jb, s, lane), fp1);
                    RWC_MMA(aY[u], fvm_j, fp2);
                    RWC_MMA(accS[u], frag_tr(IMG(B_BT), jb, s, lane), fgi);
                    RWC_MMA(accS[u], frag_tr(IMG(B_KT), jb, s, lane), fvi); }
            }
#pragma unroll
            for (int u = 0; u < 2; ++u) { const int jb = tjb[u];
                store_tile(IMG(B_XA), ib, jb, lane, aY[u]);
                const f32x4 ge = *(const LAS f32x4*)(gend + 16 * jb + 4 * lg);
                accS[u] = accS[u] * ge;
                store_tile(s_nxt, ib, jb, lane, accS[u]); }
        }
        RWC_BAR();
        {
            const size_t m = mb + (size_t)ch * 64 + et;
            const v4u yw = *(const LAS v4u*)(IMG(B_XA) + (et * PITCH + ec0) * 2), vw = *(const LAS v4u*)(IMG(B_VT) + (et * PITCH + ec0) * 2);
            const float bs = bonus[(ch & 1) * 64 + et];
            float y[8], vv[8], g[8]; float sm = 0.f;
#pragma unroll
            for (int j = 0; j < 4; ++j) { y[2 * j] = bflo(yw[j]); y[2 * j + 1] = bfhi(yw[j]); vv[2 * j] = bflo(vw[j]); vv[2 * j + 1] = bfhi(vw[j]); g[2 * j] = bflo(gw[j]); g[2 * j + 1] = bfhi(gw[j]); }
#pragma unroll
            for (int j = 0; j < 8; ++j) sm += y[j];
            sm = sum8(sm);
            const float mean = sm * (1.0f / 64.0f); float vs = 0.f;
#pragma unroll
            for (int j = 0; j < 8; ++j) { const float dl = y[j] - mean; vs += dl * dl; }
            vs = sum8(vs);
            const float rstd = __builtin_amdgcn_rsqf(vs * (1.0f / 64.0f) + 64e-5f);
            float o[8];
#pragma unroll
            for (int j = 0; j < 8; ++j) o[j] = ((y[j] - mean) * rstd * cst[8 * 64 + ec0 + j] + cst[9 * 64 + ec0 + j] + bs * vv[j]) * g[j];
            *(GAS v4u*)(yout + m * ypitch + h * 64 + ec0) = (v4u){pk2(o[0], o[1]), pk2(o[2], o[3]), pk2(o[4], o[5]), pk2(o[6], o[7])};
        }
        gw = gwn;
        if (more) {
         {
            const f32x4 c0v = *(const LAS f32x4*)(cum + et * 64 + ec0), c1v = *(const LAS f32x4*)(cum + et * 64 + ec0 + 4);
            unsigned wab[4], wbt[4], wkt[4], wrb[4], wvt[4]; float gi8[8];
#pragma unroll
            for (int j = 0; j < 8; j += 2) {
                float va[2], vb[2], vk[2], vr[2];
#pragma unroll
                for (int q = 0; q < 2; ++q) { const float ci = (j + q) < 4 ? c0v[(j + q) & 3] : c1v[(j + q) & 3];
                    const float gi = __expf(-ci), ginv = __expf(ci), ge = __expf(o_ew[j + q] - ci);
                    gi8[j + q] = gi; va[q] = o_al[j + q] * ge; vb[q] = o_be[j + q] * ginv; vk[q] = o_kf[j + q] * ginv; vr[q] = o_r[j + q] * gi; }
                wab[j >> 1] = attn_body::cvtpk_s(va[0], va[1]); wbt[j >> 1] = attn_body::cvtpk_s(vb[0], vb[1]); wkt[j >> 1] = attn_body::cvtpk_s(vk[0], vk[1]);
                wrb[j >> 1] = attn_body::cvtpk_s(vr[0], vr[1]); wvt[j >> 1] = attn_body::cvtpk_s(o_v[j], o_v[j + 1]);
            }
            const int eo = (et * PITCH + ec0) * 2;
            *(LAS v4u*)(IMG(B_AB) + eo) = (v4u){wab[0], wab[1], wab[2], wab[3]}; *(LAS v4u*)(IMG(B_BT) + eo) = (v4u){wbt[0], wbt[1], wbt[2], wbt[3]};
            *(LAS v4u*)(IMG(B_KT) + eo) = (v4u){wkt[0], wkt[1], wkt[2], wkt[3]}; *(LAS v4u*)(IMG(B_RB) + eo) = (v4u){wrb[0], wrb[1], wrb[2], wrb[3]};
            *(LAS v4u*)(IMG(B_VT) + eo) = (v4u){wvt[0], wvt[1], wvt[2], wvt[3]};
            if (et == 63) { *(LAS f32x4*)(gend + ec0) = (f32x4){gi8[0], gi8[1], gi8[2], gi8[3]}; *(LAS f32x4*)(gend + ec0 + 4) = (f32x4){gi8[4], gi8[5], gi8[6], gi8[7]}; }
        }
        }
        RWC_BAR();
    }
#undef IMG
    __syncthreads();
}
#ifndef MOE_ALIGN
#define MOE_ALIGN true
#endif
#ifndef ATTN_VAR1
#define ATTN_VAR1 0
#endif
struct Args { const float* in[30]; float* out; unsigned char* ws; int ph_lo, ph_hi, li, pad; };
__global__ void __launch_bounds__(NWAVES * 64, 2) mk_fwd(Args args) {
    extern __shared__ __attribute__((aligned(16))) unsigned char lds[];
    Frame F;
    F.lds = (LAS unsigned char*)lds;
    F.MISC = (volatile LAS unsigned*)(F.lds + MISC_OFF);
    F.tid = threadIdx.x; F.lane = F.tid & 63; F.wave = __builtin_amdgcn_readfirstlane(F.tid >> 6);
    F.G = gridDim.x; { const int bx = blockIdx.x; F.vcu = (F.G % 8 == 0) ? (bx % 8) * (F.G / 8) + bx / 8 : bx; }
    F.ws = args.ws; F.out = args.out; F.ctl = (unsigned*)(args.ws + WS_CTL);
    F.in = (in_tab_t)(args.in); F.z = 0;
    for (int u = F.tid; u < (LDS_BYTES - LDSCTL_OFF) / 4; u += NWAVES * 64) ((LAS unsigned*)(F.lds + LDSCTL_OFF))[u] = 0u;
    __syncthreads();
    const int lo = args.ph_lo, hi = args.ph_hi;
    XcdBarrier bar; bar.bar = F.ctl + CW_BAR + args.li * XCD_BAR_WORDS; bar.x = 0; bar.st = nullptr;
    if (hi - lo > 1) bar = xcd_barrier_post(F.ctl + CW_BAR + args.li * XCD_BAR_WORDS, F.MISC + 8, F.tid);
#ifndef PH_MASK
#define PH_MASK 0xfff
#endif
#define IN(k) ((((PH_MASK) >> (k)) & 1) && lo <= (k) && (k) < hi)
#define SEAM(k) do { if (IN(k) && IN((k) + 1)) { asm volatile("" : "+v"(F.tid)); xcd_barrier(bar, F.tid); } } while (0)
    bf16* const pbuf = (bf16*)(F.ws + WS_P);

    if (IN(0)) { LAUNDER(F); p0_prologue(F); SEAM(0); }
    if (IN(1)) { LAUNDER(F); p1_norm1(F); SEAM(1); }
    if (IN(2)) { LAUNDER(F);
#if P2F8 == 0
        pg8::Gemm g{(const bf16*)(F.ws + WS_H), (const bf16*)(F.ws + WS_WIN), D, 0}; pg8::StaticOrder S; S.init(T / 256, NP / 256, F.G, (int)blockIdx.x);
        pg8::EpiBf16K E{pbuf, NP, 1.0f, F.in[19 + F.z], 9};
        pg8::gemm_phase<pg8::EpiBf16K, pg8::StaticOrder, false>(F.lds, g, S, E, nullptr, F.tid);
#elif P2F8 == 3
        pg8::Gemm g{(const bf16*)(F.ws + WS_H8), (const bf16*)(F.ws + WS_WIN8), D, 0}; pg8::StaticOrder S; S.init(T / 256, NP / 256, F.G, (int)blockIdx.x);
        pg8::EpiBf16K E{pbuf, NP, 1.0f / (H_SCALE * W_SCALE), F.in[19 + F.z], 9};
        pg8::gemm_phase<pg8::EpiBf16K, pg8::StaticOrder, false, true>(F.lds, g, S, E, nullptr, F.tid);
#else
        constexpr int T8_LO = P2F8 == 1 ? 0 : 7, T8_N = P2F8 == 1 ? 7 : 8, TB_LO = P2F8 == 1 ? 7 : 0, TB_N = 15 - T8_N;
        { pg8::Gemm g{(const bf16*)(F.ws + WS_H8), (const bf16*)((const unsigned char*)(F.ws + WS_WIN8) + (size_t)T8_LO * 256 * D), D, 0}; pg8::StaticOrder S; S.init(T / 256, T8_N, F.G, (int)blockIdx.x);
          pg8::EpiBf16 E{pbuf + T8_LO * 256, NP, nullptr, 0, 1.0f / (H_SCALE * W_SCALE)};
          pg8::gemm_phase<pg8::EpiBf16, pg8::StaticOrder, false, true>(F.lds, g, S, E, nullptr, F.tid); }
        __syncthreads();
        { pg8::Gemm g{(const bf16*)(F.ws + WS_H), (const bf16*)(F.ws + WS_WIN) + (size_t)TB_LO * 256 * D, D, 0}; pg8::StaticOrder S; S.init(T / 256, TB_N, F.G, (int)blockIdx.x);
          pg8::EpiBf16 E{pbuf + TB_LO * 256, NP, nullptr, 0, 1.0f};
          pg8::gemm_phase<pg8::EpiBf16, pg8::StaticOrder, false>(F.lds, g, S, E, nullptr, F.tid); }
#endif
        SEAM(2);
    }
    if (IN(3)) { LAUNDER(F); p3_prep(F); SEAM(3); }
    if (IN(4)) { LAUNDER(F);
        pg8::Gemm g{(const bf16*)(F.ws + WS_ALORA), (const bf16*)(F.ws + WS_WLORA), KLORA, 0}; pg8::StaticOrder S; S.init(T / 256, NLORA / 256, F.G, (int)blockIdx.x);
        pg8::EpiBf16 E{(bf16*)(F.ws + WS_LORA), NLORA, nullptr, 0, 1.0f};
        pg8::gemm_phase<pg8::EpiBf16, pg8::StaticOrder, false>(F.lds, g, S, E, nullptr, F.tid);
        SEAM(4);
    }
    if (IN(5)) { LAUNDER(F);
        #ifdef RWKV_SEQ
        if (!(args.pad & 1)) for (int u = F.vcu; u < BATCH * 8; u += F.G) rwkv_unit(F, u);
#else
        if (!(args.pad & 1)) for (int u = F.vcu; u < BATCH * 8; u += F.G) rwkv_unit_chunked(F, u, (bf16*)(F.ws + WS_H), D, args.pad);
#endif
#ifdef RWC_CMP
        for (int u = F.vcu; u < BATCH * 8; u += F.G) {
            bf16* ychk = (bf16*)(F.ws + 960 * MiB);
            rwkv_unit_chunked(F, u, ychk, 512);
            __syncthreads();
            float e2 = 0.f, r2 = 0.f; const int bq = u >> 3, hq = u & 7;
            for (int idx = F.tid; idx < RWC_CMP * 64; idx += NWAVES * 64) { const size_t m = (size_t)bq * SEQ + RWC_CMP0 + (idx >> 6); const int c = hq * 64 + (idx & 63);
                const float a = bflo(((const bf16*)(F.ws + WS_H))[m * D + c]), bb = bflo(ychk[m * 512 + c]); e2 += (a - bb) * (a - bb); r2 += a * a; }
            e2 = wave_sum(e2); r2 = wave_sum(r2);
#if !defined(RWC_CHKX) && !defined(RWC_CHKL)
            if (F.lane == 0) { atomicAdd((float*)(F.ctl + 600), e2); atomicAdd((float*)(F.ctl + 601), r2); }
#endif
        }
#endif
#ifdef DUP_RWKV
        for (int u = F.vcu; u < BATCH * 8; u += F.G) rwkv_unit_chunked(F, u, (bf16*)(F.ws + WS_H), D, 0);
#endif
        if (!(args.pad & 2)) {
        __syncthreads();
        int cur_bh = -1;
        const attn_body::bf16* pb = (const attn_body::bf16*)pbuf;
        for (int ui = F.vcu; ui < BATCH * 8 * (SEQ / 256); ui += F.G) {
            const int bh = ui & 255, qb = ui >> 8;
            if (bh != cur_bh) { __syncthreads();
                fox_bias_table(F, bh, (LAS float*)(F.lds + attn_body::LDS_BIAS), (LAS float*)(F.lds + attn_body::LDS_WS));
                cur_bh = bh; __syncthreads(); }
            attn_body::attn_unit<8, ATTN_VAR1>(bh >> 3, bh & 7, qb, pb + 1792, pb + 2304, pb + 2816, pb + 3328, F.in[20 + F.z], F.in[18 + F.z], (attn_body::bf16*)(F.ws + WS_H) + 512, (char*)lds, F.tid);
        }
        }
#ifdef DUP_ATTN
        if (!(args.pad & 2)) {
        __syncthreads();
        int cur_bh = -1;
        const attn_body::bf16* pb = (const attn_body::bf16*)pbuf;
        for (int ui = F.vcu; ui < BATCH * 8 * (SEQ / 256); ui += F.G) {
            const int bh = ui & 255, qb = ui >> 8;
            if (bh != cur_bh) { __syncthreads();
                fox_bias_table(F, bh, (LAS float*)(F.lds + attn_body::LDS_BIAS), (LAS float*)(F.lds + attn_body::LDS_WS));
                cur_bh = bh; __syncthreads(); }
            attn_body::attn_unit<8>(bh >> 3, bh & 7, qb, pb + 1792, pb + 2304, pb + 2816, pb + 3328, F.in[20 + F.z], F.in[18 + F.z], (attn_body::bf16*)(F.ws + WS_H) + 512, (char*)lds, F.tid);
        }
        }
#endif
        SEAM(5);
    }
    if (IN(6)) { LAUNDER(F);
        pg8::Gemm g{(const bf16*)(F.ws + WS_H), (const bf16*)(F.ws + WS_WOUT), D, 0}; pg8::StaticOrder S; S.init(T / 256, D / 256, F.G, (int)blockIdx.x);
        pg8::EpiResGate E{F.in[0 + F.z], (bf16*)(F.ws + WS_X1), D, (const float*)(F.ws + WS_MOD) + 2048, 6144, SEQ / 256};
        pg8::gemm_phase<pg8::EpiResGate, pg8::StaticOrder, false>(F.lds, g, S, E, nullptr, F.tid);
        SEAM(6);
    }
    if (IN(7)) { LAUNDER(F);
        const int nblk7 = T / 16, per7 = (nblk7 + F.G - 1) / F.G;
        if (per7 * F.G == nblk7 && SEQ % (per7 * 16) == 0) p5_norm2_router_w(F, per7); else p5_norm2_router(F, args.pad);
        SEAM(7); }
    if (IN(8)) { LAUNDER(F); p6_positions(F); SEAM(8); }
    if (IN(9)) { LAUNDER(F);
        const int NB = moe_tables(F);
        pg8::MoeOrder S; S.so.init(NB, 2 * DE / 256, F.G, (int)blockIdx.x); S.blk2e = (const LAS unsigned char*)(F.lds + BLK2E_OFF);
        LAS unsigned short* rowtab = (LAS unsigned short*)(F.lds + AUX_OFF);
        { const LAS unsigned short* blkvalid = (const LAS unsigned short*)(F.lds + BLKVALID_OFF); const int* stok = (const int*)(F.ws + WS_STOK);
          int nun = 0; { pg8::Unit u; while (nun < ROWTAB_UNITS && S.next(nun, u)) ++nun; }
          for (int q = F.tid; q < nun * 256; q += NWAVES * 64) { pg8::Unit u; S.next(q >> 8, u); const int r = q & 255; const int rr = r < (int)blkvalid[u.pm] ? r : 0; rowtab[q] = (unsigned short)stok[u.pm * 256 + rr]; }
          __syncthreads(); }
        pg8::Gemm g{(const bf16*)(F.ws + WS_H2), (const bf16*)(F.ws + WS_WGU), D, (size_t)2 * DE * D};
        pg8::EpiSwigluFp8 E{(unsigned char*)(F.ws + WS_ACT), DE, F.in[26 + F.z], 2 * DE, DE, 1.0f / (H2_SCALE * W_SCALE), ACT_SCALE};
        pg8::gemm_phase<pg8::EpiSwigluFp8, pg8::MoeOrder, true, true, MOE_ALIGN>(F.lds, g, S, E, rowtab, F.tid);
        SEAM(9);
    }
    if (IN(10)) { LAUNDER(F);
        const int NB = moe_tables(F);
        pg8::MoeOrder S; S.so.init(NB, D / 256, F.G, (int)blockIdx.x); S.blk2e = (const LAS unsigned char*)(F.lds + BLK2E_OFF);
        pg8::Gemm g{(const bf16*)(F.ws + WS_ACT), (const bf16*)(F.ws + WS_WD), DE, (size_t)DE * D};
        pg8::EpiFp8 E{(unsigned char*)(F.ws + WS_YS), D, F.in[28 + F.z], D, 1.0f / (ACT_SCALE * W_SCALE), YS_SCALE};
        pg8::gemm_phase<pg8::EpiFp8, pg8::MoeOrder, false, true, MOE_ALIGN>(F.lds, g, S, E, nullptr, F.tid);
        SEAM(10);
    }
    if (IN(11)) { LAUNDER(F); p9_combine(F); }
#undef IN
#undef SEAM
}

extern "C" void kernel_launch(void* const* d_in, const int* in_sizes, int n_in, void* d_out, int out_size, void* d_ws, size_t ws_size, hipStream_t stream) {
    static int grid = 0;
    if (grid == 0) {
        if (n_in != 30 || out_size != T * D || ws_size < WS_END) { fprintf(stderr, "kernel_launch: unexpected problem (n_in %d, out %d, ws %zu)\n", n_in, out_size, ws_size); grid = -1; return; }
        int dev = 0, cus = 0;
        if (hipGetDevice(&dev) != hipSuccess || hipDeviceGetAttribute(&cus, hipDeviceAttributeMultiprocessorCount, dev) != hipSuccess) { grid = -1; return; }
        if (hipFuncSetAttribute((const void*)mk_fwd, hipFuncAttributeMaxDynamicSharedMemorySize, LDS_BYTES) != hipSuccess) { fprintf(stderr, "kernel_launch: hipFuncSetAttribute failed\n"); grid = -1; return; }
        int per_cu = 0;
        if (hipOccupancyMaxActiveBlocksPerMultiprocessor(&per_cu, (const void*)mk_fwd, NWAVES * 64, LDS_BYTES) != hipSuccess || per_cu < 1) fprintf(stderr, "kernel_launch: occupancy query reports %d\n", per_cu);
        (void)hipGetLastError();
        grid = cus;
    }
    if (grid < 0) return;
    if (hipMemsetAsync((char*)d_ws + WS_CTL, 0, CTL_ZERO_BYTES, stream) != hipSuccess) return;
    Args a{};
    for (int i = 0; i < 30; ++i) a.in[i] = (const float*)d_in[i];
    a.out = (float*)d_out; a.ws = (unsigned char*)d_ws; a.pad = 0;
    constexpr int NL = MK_N_LAUNCHES;
    for (int li = 0; li < NL; ++li) {
        a.ph_lo = (NL == 1) ? 0 : li; a.ph_hi = (NL == 1) ? N_PHASES : li + 1; a.li = li;
        hipLaunchKernelGGL(mk_fwd, dim3(grid), dim3(NWAVES * 64), LDS_BYTES, stream, a);
    }
#ifdef PROBE_PHASE
    a.ph_lo = PROBE_PHASE; a.ph_hi = PROBE_PHASE + 1; a.li = 1;
#ifdef PROBE_FLAGS
    a.pad = PROBE_FLAGS;
#endif
    hipLaunchKernelGGL(mk_fwd, dim3(grid), dim3(NWAVES * 64), LDS_BYTES, stream, a);
#endif
}
```
